# Optimizing an MI355X kernel written in HIP

```python
import math
import jax, jax.numpy as jnp
from jax import lax
import numpy as np

D_MODEL = 1024
BATCH = 2
SEQ = 8192
DEPTH = 2

CHUNK = 64
N_MEM = 256
SB_HEADS = 8
SB_HEAD_DIM = 64
SB_WIDTH = SB_HEADS * SB_HEAD_DIM
SB_BLOCK = 128
CONV_CH = 256
CONV_WIDTH = 31
SSM_CH = 256
SSM_GROUP = 16
SSM_GROUPS = SSM_CH // SSM_GROUP
SSM_STATE = 64
MIX_WIDTH = SB_WIDTH + CONV_CH + SSM_CH
IN_PROJ = 3 * SB_WIDTH + 2 * CONV_CH + SSM_CH
XA_HEADS = 4
XA_HEAD_DIM = D_MODEL // XA_HEADS
XA_WIDTH = XA_HEADS * XA_HEAD_DIM
FFN_HIDDEN = ((int(math.ceil(8 * D_MODEL / 3)) + 255) // 256) * 256
EPS = 1e-6

kernel_name = "hybrid_sb_conformer_s5_encoder"


def rms_norm(x, g):
    xf = x.astype(jnp.float32)
    y = xf * lax.rsqrt(jnp.mean(xf * xf, axis=-1, keepdims=True) + EPS)
    return (y * g.astype(jnp.float32)).astype(x.dtype)


def layer_norm(x, g, b):
    xf = x.astype(jnp.float32)
    mu = jnp.mean(xf, axis=-1, keepdims=True)
    var = jnp.mean(jnp.square(xf - mu), axis=-1, keepdims=True)
    y = (xf - mu) * lax.rsqrt(var + EPS)
    return (y * g.astype(jnp.float32) + b.astype(jnp.float32)).astype(x.dtype)


def stick_breaking_attention(q, k, v):
    bsz, L, H, hd = q.shape
    nb = L // SB_BLOCK
    kh = k.transpose(0, 2, 1, 3)
    vh = v.transpose(0, 2, 1, 3)
    q_blocks = q.transpose(0, 2, 1, 3).reshape(bsz, H, nb, SB_BLOCK, hd).transpose(2, 0, 1, 3, 4)
    key_pos = jnp.arange(L)
    scale = hd ** -0.5

    def one_block(args):
        qb, blk = args
        z = jnp.einsum('bhqd,bhkd->bhqk', qb, kh).astype(jnp.float32) * scale
        q_pos = blk * SB_BLOCK + jnp.arange(SB_BLOCK)
        mask = key_pos[None, :] < q_pos[:, None]
        log_1mb = jnp.where(mask, jax.nn.log_sigmoid(-z), 0.0)
        later = lax.cumsum(log_1mb, axis=3, reverse=True) - log_1mb
        w = jnp.where(mask, jnp.exp(jax.nn.log_sigmoid(z) + later), 0.0)
        return jnp.einsum('bhqk,bhkd->bhqd', w.astype(vh.dtype), vh)

    out = lax.map(one_block, (q_blocks, jnp.arange(nb)))
    return out.transpose(1, 0, 3, 2, 4).reshape(bsz, L, H * hd)


def conformer_conv(u2, dw_w, dw_b, ln_g, ln_b, pw2_w):
    a, b = jnp.split(u2, 2, axis=-1)
    h = a * jax.nn.sigmoid(b)
    h = lax.conv_general_dilated(
        h, dw_w[:, None, :].astype(h.dtype), window_strides=(1,),
        padding=((CONV_WIDTH - 1, 0),), dimension_numbers=('NWC', 'WIO', 'NWC'),
        feature_group_count=CONV_CH) + dw_b
    h = jax.nn.silu(layer_norm(h, ln_g, ln_b))
    return h @ pw2_w


def s5_ssm(u, lam_re, lam_im, log_dt, b_re, b_im, c_re, c_im, d, glu_w):
    bsz, L, _ = u.shape
    f32 = jnp.float32
    uf = u.astype(f32).reshape(bsz, L, SSM_GROUPS, SSM_GROUP)
    lr, li = lam_re.astype(f32), lam_im.astype(f32)
    dt = jnp.exp(log_dt.astype(f32))[:, None]
    mag = jnp.exp(lr * dt)
    ar, ai = mag * jnp.cos(li * dt), mag * jnp.sin(li * dt)
    den = lr * lr + li * li
    fr = ((ar - 1.0) * lr + ai * li) / den
    fi = (ai * lr - (ar - 1.0) * li) / den
    br, bi = b_re.astype(f32), b_im.astype(f32)
    bbr = fr[..., None] * br - fi[..., None] * bi
    bbi = fr[..., None] * bi + fi[..., None] * br
    bu_r = jnp.einsum('blgh,gph->blgp', uf, bbr)
    bu_i = jnp.einsum('blgh,gph->blgp', uf, bbi)
    shape = bu_r.shape
    a_r = jnp.broadcast_to(ar, shape)
    a_i = jnp.broadcast_to(ai, shape)

    def combine(e1, e2):
        a1r, a1i, b1r, b1i = e1
        a2r, a2i, b2r, b2i = e2
        return (a2r * a1r - a2i * a1i,
                a2r * a1i + a2i * a1r,
                a2r * b1r - a2i * b1i + b2r,
                a2r * b1i + a2i * b1r + b2i)

    _, _, xr, xi = lax.associative_scan(combine, (a_r, a_i, bu_r, bu_i), axis=1)
    y = (jnp.einsum('blgp,ghp->blgh', xr, c_re.astype(f32))
         - jnp.einsum('blgp,ghp->blgh', xi, c_im.astype(f32)))
    y = y.reshape(bsz, L, SSM_CH) + d.astype(f32) * uf.reshape(bsz, L, SSM_CH)
    y = y.astype(u.dtype)
    ya, yb = jnp.split(y @ glu_w, 2, axis=-1)
    return ya * jax.nn.sigmoid(yb)


def memory_cross_attention(h, m, wq, wk, wv, q_g, k_g, wo):
    bsz, L, _ = h.shape
    q = rms_norm((h @ wq).reshape(bsz, L, XA_HEADS, XA_HEAD_DIM), q_g)
    k = rms_norm((m @ wk).reshape(bsz, N_MEM, XA_HEADS, XA_HEAD_DIM), k_g)
    v = (m @ wv).reshape(bsz, N_MEM, XA_HEADS, XA_HEAD_DIM)
    s = jnp.einsum('blhd,bmhd->bhlm', q, k).astype(jnp.float32) * (XA_HEAD_DIM ** -0.5)
    p = jax.nn.softmax(s, axis=-1).astype(v.dtype)
    o = jnp.einsum('bhlm,bmhd->blhd', p, v).reshape(bsz, L, XA_WIDTH)
    return o @ wo


def setup_inputs(seed: int = 0) -> dict:
    key = jax.random.key(seed)
    ks = iter(jax.random.split(key, 40))
    f32 = jnp.float32

    def nrm(shape, scale):
        return jax.random.normal(next(ks), shape, f32) * scale

    def gain(shape):
        return 1.0 + 0.02 * jax.random.normal(next(ks), shape, f32)

    n_idx = jnp.arange(SSM_STATE, dtype=f32)
    return {
        "x": nrm((BATCH, SEQ, D_MODEL), 1.0),
        "mem": nrm((BATCH, N_MEM, D_MODEL), 1.0),
        "norm_mix_g": gain((DEPTH, D_MODEL)),
        "w_in": nrm((DEPTH, D_MODEL, IN_PROJ), D_MODEL ** -0.5),
        "sb_q_norm_g": gain((DEPTH, SB_HEAD_DIM)),
        "sb_k_norm_g": gain((DEPTH, SB_HEAD_DIM)),
        "conv_dw_w": nrm((DEPTH, CONV_WIDTH, CONV_CH), CONV_WIDTH ** -0.5),
        "conv_dw_b": nrm((DEPTH, CONV_CH), 0.02),
        "conv_ln_g": gain((DEPTH, CONV_CH)),
        "conv_ln_b": nrm((DEPTH, CONV_CH), 0.02),
        "conv_pw2_w": nrm((DEPTH, CONV_CH, CONV_CH), CONV_CH ** -0.5),
        "ssm_lam_re": -0.5 * jnp.exp(nrm((DEPTH, SSM_GROUPS, SSM_STATE), 0.05)),
        "ssm_lam_im": jnp.pi * n_idx * jnp.exp(nrm((DEPTH, SSM_GROUPS, SSM_STATE), 0.01)),
        "ssm_log_dt": jax.random.uniform(next(ks), (DEPTH, SSM_GROUPS), f32,
                                         math.log(1e-3), math.log(1e-1)),
        "ssm_b_re": nrm((DEPTH, SSM_GROUPS, SSM_STATE, SSM_GROUP), (2 * SSM_GROUP) ** -0.5),
        "ssm_b_im": nrm((DEPTH, SSM_GROUPS, SSM_STATE, SSM_GROUP), (2 * SSM_GROUP) ** -0.5),
        "ssm_c_re": nrm((DEPTH, SSM_GROUPS, SSM_GROUP, SSM_STATE), (2 * SSM_STATE) ** -0.5),
        "ssm_c_im": nrm((DEPTH, SSM_GROUPS, SSM_GROUP, SSM_STATE), (2 * SSM_STATE) ** -0.5),
        "ssm_d": nrm((DEPTH, SSM_CH), 1.0),
        "ssm_glu_w": nrm((DEPTH, SSM_CH, 2 * SSM_CH), SSM_CH ** -0.5),
        "branch_norm_g": gain((DEPTH, MIX_WIDTH)),
        "w_out": nrm((DEPTH, MIX_WIDTH, D_MODEL), MIX_WIDTH ** -0.5),
        "norm_xa_g": gain((DEPTH, D_MODEL)),
        "norm_mem_g": gain((DEPTH, D_MODEL)),
        "xa_wq": nrm((DEPTH, D_MODEL, XA_WIDTH), D_MODEL ** -0.5),
        "xa_wk": nrm((DEPTH, D_MODEL, XA_WIDTH), D_MODEL ** -0.5),
        "xa_wv": nrm((DEPTH, D_MODEL, XA_WIDTH), D_MODEL ** -0.5),
        "xa_q_norm_g": gain((DEPTH, XA_HEAD_DIM)),
        "xa_k_norm_g": gain((DEPTH, XA_HEAD_DIM)),
        "xa_wo": nrm((DEPTH, XA_WIDTH, D_MODEL), XA_WIDTH ** -0.5),
        "norm_ffn_g": gain((DEPTH, D_MODEL)),
        "ffn_w_in": nrm((DEPTH, D_MODEL, 2 * FFN_HIDDEN), D_MODEL ** -0.5),
        "ffn_w_out": nrm((DEPTH, FFN_HIDDEN, D_MODEL), FFN_HIDDEN ** -0.5),
    }


def reference(x, mem, norm_mix_g, w_in, sb_q_norm_g, sb_k_norm_g, conv_dw_w, conv_dw_b,
              conv_ln_g, conv_ln_b, conv_pw2_w, ssm_lam_re, ssm_lam_im, ssm_log_dt,
              ssm_b_re, ssm_b_im, ssm_c_re, ssm_c_im, ssm_d, ssm_glu_w, branch_norm_g,
              w_out, norm_xa_g, norm_mem_g, xa_wq, xa_wk, xa_wv, xa_q_norm_g, xa_k_norm_g,
              xa_wo, norm_ffn_g, ffn_w_in, ffn_w_out):
    bsz, L, _ = x.shape
    s1 = SB_WIDTH
    s2 = 2 * SB_WIDTH
    s3 = 3 * SB_WIDTH
    s4 = s3 + 2 * CONV_CH
    for l in range(DEPTH):
        h = rms_norm(x, norm_mix_g[l])
        p = h @ w_in[l]
        q = rms_norm(p[..., :s1].reshape(bsz, L, SB_HEADS, SB_HEAD_DIM), sb_q_norm_g[l])
        k = rms_norm(p[..., s1:s2].reshape(bsz, L, SB_HEADS, SB_HEAD_DIM), sb_k_norm_g[l])
        v = p[..., s2:s3].reshape(bsz, L, SB_HEADS, SB_HEAD_DIM)
        o_sb = stick_breaking_attention(q, k, v)
        o_conv = conformer_conv(p[..., s3:s4], conv_dw_w[l], conv_dw_b[l],
                                conv_ln_g[l], conv_ln_b[l], conv_pw2_w[l])
        o_ssm = s5_ssm(p[..., s4:], ssm_lam_re[l], ssm_lam_im[l], ssm_log_dt[l],
                       ssm_b_re[l], ssm_b_im[l], ssm_c_re[l], ssm_c_im[l],
                       ssm_d[l], ssm_glu_w[l])
        g = branch_norm_g[l]
        mixed = jnp.concatenate([
            rms_norm(o_sb, g[:SB_WIDTH]),
            rms_norm(o_conv, g[SB_WIDTH:SB_WIDTH + CONV_CH]),
            rms_norm(o_ssm, g[SB_WIDTH + CONV_CH:]),
        ], axis=-1)
        x = x + mixed @ w_out[l]
        hx = rms_norm(x, norm_xa_g[l])
        hm = rms_norm(mem, norm_mem_g[l])
        x = x + memory_cross_attention(hx, hm, xa_wq[l], xa_wk[l], xa_wv[l],
                                       xa_q_norm_g[l], xa_k_norm_g[l], xa_wo[l])
        hf = rms_norm(x, norm_ffn_g[l])
        gate, up = jnp.split(hf @ ffn_w_in[l], 2, axis=-1)
        x = x + (jax.nn.silu(gate) * up) @ ffn_w_out[l]
    return x
```

```cpp
#include <hip/hip_runtime.h>
#include <hip/hip_cooperative_groups.h>
#include <cstdio>
#include <cstdint>
namespace cg = cooperative_groups;

#define LAS __attribute__((address_space(3)))
typedef unsigned short bf16_t;
typedef short bf16x8 __attribute__((ext_vector_type(8)));
typedef short s16x4 __attribute__((ext_vector_type(4)));
typedef float f32x4 __attribute__((ext_vector_type(4)));
typedef float f32x2 __attribute__((ext_vector_type(2)));
typedef float f32x16 __attribute__((ext_vector_type(16)));
typedef unsigned u32x4 __attribute__((ext_vector_type(4)));
typedef unsigned u32x2 __attribute__((ext_vector_type(2)));

constexpr int BATCH = 2, SEQ = 8192, DM = 1024, M = BATCH * SEQ, DEPTH = 2;
constexpr int NIN = 2304, FFH = 2816, NMEM = 256;
constexpr float EPS = 1e-6f;
constexpr float LOG2E = 1.4426950408889634f;
constexpr int NWAVES = 8;

constexpr size_t MiB = 1u << 20;
constexpr size_t WS_SS = 0;
constexpr size_t WS_BAR = 768 * 1024;
constexpr size_t WS_W = 1 * MiB;
constexpr size_t WL_IN = 0, WL_OUT = 4718592, WL_Q = 6815744, WL_O = 8912896, WL_FFI = 11010048, WL_FFO = 22544384, WL_PW2 = 28311552, WL_GLU = 28442624, WL_STRIDE = 28704768;
constexpr size_t WS_WKV = WS_W + 2 * WL_STRIDE;
constexpr size_t WS_XB = 64 * MiB;
constexpr size_t WS_RA = 96 * MiB;
constexpr size_t WS_Q = WS_RA, WS_K = WS_RA + 16 * MiB, WS_VT = WS_RA + 32 * MiB, WS_HC = WS_RA + 48 * MiB, WS_U = WS_RA + 56 * MiB,
                 WS_AC = WS_RA + 64 * MiB, WS_YS = WS_RA + 72 * MiB, WS_KRAW = WS_RA + 80 * MiB;
constexpr size_t WS_HF = WS_RA;
constexpr size_t WS_MIX = 184 * MiB;
constexpr size_t WS_XL = 216 * MiB;
constexpr size_t WS_SSQ = 255 * MiB;
constexpr size_t WS_SST = 248 * MiB, WS_KP = 250 * MiB, WS_VTM = 252 * MiB, WS_HMN = 254 * MiB;
static_assert(WS_WKV + 2 * 2048 * 1024 * 2 <= WS_XB, "weights fit");

enum { SS_MIX = 0, SS_SB = 1, SS_CONV = 2, SS_SSM = 3, SS_XA = 4, SS_FFN = 5 };

typedef __bf16 bf16x2_t __attribute__((ext_vector_type(2)));
__device__ __forceinline__ unsigned cvt_pk_bf16(float lo, float hi) { f32x2 v = {lo, hi}; bf16x2_t b = __builtin_convertvector(v, bf16x2_t); return __builtin_bit_cast(unsigned, b); }
__device__ __forceinline__ bf16_t f2bf(float f) { unsigned u = __builtin_bit_cast(unsigned, f); return (bf16_t)((u + 0x7fffu + ((u >> 16) & 1u)) >> 16); }
__device__ __forceinline__ float bf2f(unsigned short b) { return __builtin_bit_cast(float, (unsigned)b << 16); }
__device__ __forceinline__ float bflo(unsigned w) { return __builtin_bit_cast(float, w << 16); }
__device__ __forceinline__ float bfhi(unsigned w) { return __builtin_bit_cast(float, w & 0xffff0000u); }
__device__ __forceinline__ float ex2(float x) { return __builtin_amdgcn_exp2f(x); }
__device__ __forceinline__ float lg2(float x) { return __builtin_amdgcn_logf(x); }
__device__ __forceinline__ float sigmoidf_(float x) { return __builtin_amdgcn_rcpf(1.f + ex2(-x * LOG2E)); }
__device__ __forceinline__ int crow(int r, int hi) { return (r & 3) + 8 * (r >> 2) + 4 * hi; }
template <int MASK> __device__ __forceinline__ float xshfl(float v) {
    if constexpr (MASK == 32) {
        const unsigned u = __builtin_bit_cast(unsigned, v);
        auto rr = __builtin_amdgcn_permlane32_swap(u, u, false, false);
        const bool up = (__builtin_amdgcn_mbcnt_hi(~0u, __builtin_amdgcn_mbcnt_lo(~0u, 0u)) & 32u) != 0u;
        return __builtin_bit_cast(float, up ? (unsigned)rr[0] : (unsigned)rr[1]);
    } else {
        return __builtin_bit_cast(float, __builtin_amdgcn_ds_swizzle(__builtin_bit_cast(int, v), (MASK << 10) | 0x1f));
    }
}
__device__ __forceinline__ float wave_sum(float v) {
    v += xshfl<1>(v); v += xshfl<2>(v); v += xshfl<4>(v); v += xshfl<8>(v); v += xshfl<16>(v); v += xshfl<32>(v);
    return v;
}
#define MFMA32(a, b, c) __builtin_amdgcn_mfma_f32_32x32x16_bf16((a), (b), (c), 0, 0, 0)
#define MFMA16(a, b, c) __builtin_amdgcn_mfma_f32_16x16x32_bf16((a), (b), (c), 0, 0, 0)

namespace pg8 {
constexpr int BM = 256, BK = 64, HALF = 128, HTB = HALF * BK * 2, STAGE_BYTES = 8 * HTB, NXCD = 8, WGM = 8;
__device__ __forceinline__ int lds_byte(int r, int c) { const int st = (r >> 4) * 2 + (c >> 5), rr = r & 15, cc = c & 31, ob = rr * 64 + cc * 2; return st * 1024 + (ob ^ (((ob >> 9) & 1) << 5)); }
__device__ __forceinline__ void stage_rc(int b, int& R, int& C) { const int st = b / 1024, sb = b % 1024, swz = sb ^ (((sb >> 9) & 1) << 5); R = (st >> 1) * 16 + swz / 64; C = (st & 1) * 32 + (swz % 64) / 2; }
__device__ __forceinline__ int perm32(int rho) { const int n = rho >> 4, i = rho & 15; return 8 * (i >> 2) + 4 * n + (i & 3); }

struct Unit { int pm, pn, prob; const char* a; const char* b; };
struct Sched {
    const char *A0, *A1, *B0, *B1; int nM0, nM1, nN0, nN1; int np, K, G, c;
    __device__ __forceinline__ int lda() const { return K; }
    __device__ __forceinline__ int ldb() const { return K; }
    __device__ __forceinline__ bool next(int i, Unit& u) const {
        long L = (long)i * G + c; int p = 0;
        const int n0 = nM0 * nN0;
        if (L >= n0) { if (np < 2) return false; L -= n0; p = 1; if (L >= nM1 * nN1) return false; }
        const int nm = p ? nM1 : nM0, nn = p ? nN1 : nN0, nwg = nm * nn;
        int wgid = (int)L; { const int q = nwg / NXCD, r = nwg % NXCD, xcd = wgid % NXCD, off = wgid / NXCD; wgid = (xcd < r ? xcd * (q + 1) : r * (q + 1) + (xcd - r) * q) + off; }
        const int nig = WGM * nn, gid = wgid / nig, fm = gid * WGM, gsz = (nm - fm) < WGM ? (nm - fm) : WGM;
        u.pm = fm + ((wgid % nig) % gsz); u.pn = (wgid % nig) / gsz; u.prob = p;
        const size_t tstep = (size_t)BM * K * 2;
        u.a = (p ? A1 : A0) + (size_t)u.pm * tstep; u.b = (p ? B1 : B0) + (size_t)u.pn * tstep; return true;
    }
};

struct SchedXA {
    const char* A; const char* B; int K, G, c;
    __device__ __forceinline__ int lda() const { return 1024; }
    __device__ __forceinline__ int ldb() const { return 256; }
    __device__ __forceinline__ bool next(int i, Unit& u) const {
        const long L = (long)i * G + c; if (L >= 256) return false;
        const int v = (int)L, xq = v & 7, off = v >> 3, pm = 8 * xq + (off & 7), head = off >> 3, b = pm >> 5, bh = b * 4 + head;
        u.pm = pm; u.pn = head; u.prob = 0;
        u.a = A + ((size_t)u.pm * 256 * 1024 + (size_t)head * 256) * 2; u.b = B + (size_t)bh * 256 * 256 * 2; return true;
    }
};
__device__ __forceinline__ int lane_id_asm_() { int l; asm volatile("v_mbcnt_lo_u32_b32 %0, -1, 0\n\tv_mbcnt_hi_u32_b32 %0, -1, %0" : "=v"(l)); return l; }
struct NoHook { __device__ __forceinline__ void operator()(int, f32x4 (&)[2][2][4][2], int, int) const {} };
struct HookMix {
    const LAS float* fac;
    __device__ __forceinline__ void operator()(int t, f32x4 (&acc)[2][2][4][2], int wr, int fr) const {
        if (t == 8 || t == 12) {
            const int idx = (t == 8) ? 0 : 1;
#pragma unroll
            for (int ai = 0; ai < 2; ++ai)
#pragma unroll
                for (int m = 0; m < 4; ++m) {
                    const float f = fac[(ai * 128 + wr * 64 + m * 16 + fr) * 4 + idx];
#pragma unroll
                    for (int bj = 0; bj < 2; ++bj)
#pragma unroll
                        for (int n = 0; n < 2; ++n) acc[ai][bj][m][n] *= f;
                }
        }
    }
};
template <class Epi, class SchedT, class HookT = NoHook>
__device__ __forceinline__ void gemm_phase(LAS unsigned char* lds, const SchedT& S, const Epi& E, int wave_, const HookT& H = HookT()) {
    const int tid_ = wave_ * 64 + lane_id_asm_();
    int K_ = S.K; asm volatile("" : "+s"(K_));
    const int tid = tid_, wid = __builtin_amdgcn_readfirstlane(tid >> 6), lane = tid & 63, wr = wid >> 2, wc = wid & 3, fr = lane & 15, fq = lane >> 4;
    const int K = K_, nt = K / BK;
    unsigned voffA[2], voffB[2];
#pragma unroll
    for (int i = 0; i < 2; ++i) { int R, C; stage_rc(tid * 16 + i * 8192, R, C); const int Rb = (R & ~31) + perm32(R & 31);
        voffA[i] = (unsigned)(R * S.lda() + C) * 2u; voffB[i] = (unsigned)(Rb * S.ldb() + C) * 2u; }
    const size_t kstep = (size_t)(BK * 2);
    const size_t hstepA = (size_t)HALF * S.lda() * 2, hstepB = (size_t)HALF * S.ldb() * 2;
    const unsigned ldsw = (unsigned)wid * 1024u;
    const int aoff = lds_byte(wr * 64 + fr, fq * 8), boff = lds_byte(wc * 32 + fr, fq * 8);
#define PG8_SA(b, h) (((b) * 2 + (h)) * HTB)
#define PG8_SB(b, h) ((4 + (b) * 2 + (h)) * HTB)
#define PG8_STAGE(bufoff, gbase, voff) do { _Pragma("unroll") for (int _i = 0; _i < 2; ++_i) \
        __builtin_amdgcn_global_load_lds((const unsigned*)((const char*)(gbase) + (voff)[_i]), (LAS unsigned*)(lds + (bufoff) + ldsw + _i * 8192), 16, 0, 0); } while (0)
#define PG8_LDA(dst, b, h) do { _Pragma("unroll") for (int m = 0; m < 4; ++m) _Pragma("unroll") for (int k = 0; k < 2; ++k) dst[m][k] = *(const LAS bf16x8*)(lds + PG8_SA(b, h) + aoff + m * 2048 + k * 1024); } while (0)
#define PG8_LDB(dst, b, h) do { _Pragma("unroll") for (int n = 0; n < 2; ++n) _Pragma("unroll") for (int k = 0; k < 2; ++k) dst[n][k] = *(const LAS bf16x8*)(lds + PG8_SB(b, h) + boff + n * 2048 + k * 1024); } while (0)
#define PG8_MMA(ai, bj, At, Bt) do { __builtin_amdgcn_s_setprio(1); _Pragma("unroll") for (int m = 0; m < 4; ++m) _Pragma("unroll") for (int n = 0; n < 2; ++n) _Pragma("unroll") for (int k = 0; k < 2; ++k) \
        acc[ai][bj][m][n] = __builtin_amdgcn_mfma_f32_16x16x32_bf16(Bt[n][k], At[m][k], acc[ai][bj][m][n], 0, 0, 0); __builtin_amdgcn_s_setprio(0); } while (0)
#define PG8_WAIT_V(n) asm volatile("s_waitcnt vmcnt(" #n ")" ::: "memory")
#define PG8_WAIT_L(n) asm volatile("s_waitcnt lgkmcnt(" #n ")" ::: "memory")
#define PG8_BAR __builtin_amdgcn_s_barrier()
#define PG8_SCHED __builtin_amdgcn_sched_barrier(0)
    Unit cur, nxt; int ui = 0;
    if (!S.next(0, cur)) return;
    f32x4 acc[2][2][4][2];
#pragma unroll
    for (int a = 0; a < 2; ++a)
#pragma unroll
        for (int b = 0; b < 2; ++b)
#pragma unroll
            for (int m = 0; m < 4; ++m)
#pragma unroll
                for (int n = 0; n < 2; ++n) acc[a][b][m][n] = (f32x4){0.f, 0.f, 0.f, 0.f};
    bf16x8 At[4][2], B0[2][2], B1[2][2];
    const char* cA = cur.a; const char* cB = cur.b;
    PG8_STAGE(PG8_SB(0, 0), cB, voffB); PG8_STAGE(PG8_SB(0, 1), cB + hstepB, voffB); PG8_STAGE(PG8_SA(0, 0), cA, voffA); PG8_STAGE(PG8_SA(0, 1), cA + hstepA, voffA);
    if (wr == 1) PG8_BAR;
    PG8_WAIT_V(2); PG8_BAR;
    PG8_STAGE(PG8_SB(1, 0), cB + kstep, voffB); PG8_STAGE(PG8_SA(1, 0), cA + kstep, voffA); PG8_STAGE(PG8_SB(1, 1), cB + hstepB + kstep, voffB);
    PG8_WAIT_V(6); PG8_BAR;
    for (;;) {
        const bool has_next = S.next(ui + 1, nxt);
        const char* nA = has_next ? nxt.a : cA; const char* nB = has_next ? nxt.b : cB;
        for (int t = 0; t < nt; t += 2) {
            H(t, acc, wr, fr);
            const bool last = (t == nt - 2);
            const char* a1 = cA + (size_t)(t + 1) * kstep;
            const char* a2 = last ? nA : cA + (size_t)(t + 2) * kstep; const char* b2 = last ? nB : cB + (size_t)(t + 2) * kstep;
            const char* a3 = a2 + kstep; const char* b3 = b2 + kstep;
            PG8_LDB(B0, 0, 0); PG8_LDB(B1, 0, 1); PG8_SCHED; PG8_LDA(At, 0, 0); PG8_STAGE(PG8_SA(1, 1), a1 + hstepA, voffA);
            PG8_WAIT_V(8); PG8_WAIT_L(0); PG8_BAR; PG8_MMA(0, 0, At, B0); PG8_MMA(0, 1, At, B1); PG8_BAR; PG8_SCHED;
            PG8_LDA(At, 0, 1); PG8_STAGE(PG8_SB(0, 0), b2, voffB); PG8_STAGE(PG8_SB(0, 1), b2 + hstepB, voffB); PG8_STAGE(PG8_SA(0, 0), a2, voffA);
            PG8_WAIT_V(8); PG8_WAIT_L(0); PG8_BAR; PG8_MMA(1, 0, At, B0); PG8_MMA(1, 1, At, B1); PG8_BAR; PG8_SCHED;
            PG8_LDB(B0, 1, 0); PG8_LDB(B1, 1, 1); PG8_SCHED; PG8_LDA(At, 1, 0); PG8_STAGE(PG8_SA(0, 1), a2 + hstepA, voffA);
            PG8_WAIT_V(8); PG8_WAIT_L(0); PG8_BAR; PG8_MMA(0, 0, At, B0); PG8_MMA(0, 1, At, B1); PG8_BAR; PG8_SCHED;
            PG8_LDA(At, 1, 1); PG8_STAGE(PG8_SB(1, 0), b3, voffB); PG8_STAGE(PG8_SB(1, 1), b3 + hstepB, voffB); PG8_STAGE(PG8_SA(1, 0), a3, voffA);
            PG8_WAIT_V(8); PG8_WAIT_L(0); PG8_BAR; PG8_MMA(1, 0, At, B0); PG8_MMA(1, 1, At, B1); PG8_BAR; PG8_SCHED;
        }
        if (wr == 0) PG8_BAR;
        E(acc, cur, wr, wc, fr, fq);
        if (!has_next) break;
#pragma unroll
        for (int a = 0; a < 2; ++a)
#pragma unroll
            for (int b = 0; b < 2; ++b)
#pragma unroll
                for (int m = 0; m < 4; ++m)
#pragma unroll
                    for (int n = 0; n < 2; ++n) acc[a][b][m][n] = (f32x4){0.f, 0.f, 0.f, 0.f};
        cur = nxt; cA = nA; cB = nB; ++ui;
        if (wr == 1) PG8_BAR;
    }
    PG8_WAIT_V(0);
    PG8_BAR;
#undef PG8_SA
#undef PG8_SB
#undef PG8_STAGE
#undef PG8_LDA
#undef PG8_LDB
#undef PG8_MMA
#undef PG8_WAIT_V
#undef PG8_WAIT_L
#undef PG8_BAR
#undef PG8_SCHED
}
}
using pg8::Unit;
#define GASP __attribute__((address_space(1)))
__device__ __forceinline__ unsigned char* launder(unsigned char* p) { unsigned long long v = (unsigned long long)p; asm volatile("" : "+s"(v)); return (unsigned char*)(GASP unsigned char*)v; }
__device__ __forceinline__ int lane_id_asm() { int l; asm volatile("v_mbcnt_lo_u32_b32 %0, -1, 0\n\tv_mbcnt_hi_u32_b32 %0, -1, %0" : "=v"(l)); return l; }
__device__ __forceinline__ int launder_i(int v) { asm volatile("" : "+s"(v)); return v; }
#define SSP(l, k) ((float*)(ws + WS_SS) + (size_t)((l) * 6 + (k)) * M)
typedef f32x4 Acc[2][2][4][2];

__device__ __forceinline__ void st16(bf16_t* p, const float* v) {
    u32x4 w; w.x = cvt_pk_bf16(v[0], v[1]); w.y = cvt_pk_bf16(v[2], v[3]); w.z = cvt_pk_bf16(v[4], v[5]); w.w = cvt_pk_bf16(v[6], v[7]);
    *(u32x4*)p = w;
}

__device__ __forceinline__ void load_rs(float (&rs)[2][4], const float* ssx, int row0) {
#pragma unroll
    for (int ai = 0; ai < 2; ++ai)
#pragma unroll
        for (int m = 0; m < 4; ++m) rs[ai][m] = ssx[row0 + ai * 128 + m * 16];
#pragma unroll
    for (int ai = 0; ai < 2; ++ai)
#pragma unroll
        for (int m = 0; m < 4; ++m) rs[ai][m] = __builtin_amdgcn_rsqf(rs[ai][m] * (1.f / 1024.f) + EPS);
}
__device__ __forceinline__ void st16_nt(bf16_t* p, const float* v) {
    u32x4 w; w.x = cvt_pk_bf16(v[0], v[1]); w.y = cvt_pk_bf16(v[2], v[3]); w.z = cvt_pk_bf16(v[4], v[5]); w.w = cvt_pk_bf16(v[6], v[7]);
    __builtin_nontemporal_store(w, (u32x4*)p);
}
struct EpiIn {
    unsigned char* ws_; int l; const float* qg; const float* kg;
    __device__ __forceinline__ void operator()(const Acc& acc, const Unit& u, int wr, int wc, int fr, int fq) const {
        unsigned char* ws = launder(ws_);
        const float* ssx = SSP(l, SS_MIX);
        bf16_t* Q = (bf16_t*)(ws + WS_Q); bf16_t* Kb = (bf16_t*)(ws + WS_K); bf16_t* Vt = (bf16_t*)(ws + WS_VT); bf16_t* HC = (bf16_t*)(ws + WS_HC); bf16_t* U = (bf16_t*)(ws + WS_U);
        float* kraw = (float*)(ws + WS_KRAW); bf16_t* vtm = (bf16_t*)(ws + WS_VTM);
        if (u.prob == 0) {
            const int pn = u.pn;
            float rsv[2][4]; load_rs(rsv, ssx, u.pm * 256 + wr * 64 + fr);
            if (pn < 4) {
                const float* g = (pn < 2) ? qg : kg; bf16_t* dst = (pn < 2) ? Q : Kb;
                const float post = (pn < 2) ? 0.125f * LOG2E : 1.0f;
                const int head = 4 * (pn & 1) + wc;
#pragma unroll
                for (int ai = 0; ai < 2; ++ai)
#pragma unroll
                    for (int m = 0; m < 4; ++m) {
                        const int row = u.pm * 256 + ai * 128 + wr * 64 + m * 16 + fr;
                        const float rs = rsv[ai][m];
                        f32x4 v[2][2]; float ss = 0.f;
#pragma unroll
                        for (int bj = 0; bj < 2; ++bj)
#pragma unroll
                            for (int n = 0; n < 2; ++n) { v[bj][n] = acc[ai][bj][m][n] * rs; const f32x4 x = v[bj][n]; ss += (x[0] * x[0] + x[1] * x[1]) + (x[2] * x[2] + x[3] * x[3]); }
                        ss += xshfl<16>(ss); ss += xshfl<32>(ss);
                        const float hn = __builtin_amdgcn_rsqf(ss * (1.f / 64.f) + EPS) * post;
#pragma unroll
                        for (int bj = 0; bj < 2; ++bj) {
                            float o[8];
#pragma unroll
                            for (int n = 0; n < 2; ++n) { const f32x4 gv = *(const f32x4*)(g + 32 * bj + 8 * fq + 4 * n);
#pragma unroll
                                for (int j = 0; j < 4; ++j) o[4 * n + j] = v[bj][n][j] * hn * gv[j]; }
                            st16(dst + (size_t)row * 512 + head * 64 + 32 * bj + 8 * fq, o);
                        }
                        asm volatile("" ::: "memory");
                    }
            } else if (pn < 6) {
#pragma unroll
                for (int ai = 0; ai < 2; ++ai)
#pragma unroll
                    for (int m = 0; m < 4; ++m) {
                        const int row = u.pm * 256 + ai * 128 + wr * 64 + m * 16 + fr;
                        const float rs = rsv[ai][m];
                        const int b = row >> 13, t = row & (SEQ - 1);
#pragma unroll
                        for (int bj = 0; bj < 2; ++bj) {
                            const int h = 4 * (pn - 4) + 2 * bj + (wc >> 1);
                            const bool odd = (fr & 1) != 0;
#pragma unroll
                            for (int n = 0; n < 2; ++n)
#pragma unroll
                                for (int jp = 0; jp < 2; ++jp) {
                                    const float v0 = acc[ai][bj][m][n][2 * jp] * rs, v1 = acc[ai][bj][m][n][2 * jp + 1] * rs;
                                    const float send = odd ? v0 : v1;
                                    const float recv = __builtin_bit_cast(float, __builtin_amdgcn_update_dpp(0, __builtin_bit_cast(int, send), 0xB1, 0xF, 0xF, true));
                                    const int d = 32 * (wc & 1) + 8 * fq + 4 * n + 2 * jp + (odd ? 1 : 0);
                                    const unsigned w = odd ? cvt_pk_bf16(recv, v1) : cvt_pk_bf16(v0, recv);
                                    *(unsigned*)(Vt + ((size_t)(b * 8 + h) * 64 + d) * SEQ + (t & ~1)) = w;
                                }
                        }
                    }
            } else if (pn < 8) {
#pragma unroll
                for (int ai = 0; ai < 2; ++ai)
#pragma unroll
                    for (int m = 0; m < 4; ++m) {
                        const int row = u.pm * 256 + ai * 128 + wr * 64 + m * 16 + fr;
                        const float rs = rsv[ai][m];
                        float o[8];
#pragma unroll
                        for (int n = 0; n < 2; ++n)
#pragma unroll
                            for (int j = 0; j < 4; ++j) { const float a = acc[ai][0][m][n][j] * rs, b = acc[ai][1][m][n][j] * rs; o[4 * n + j] = a * sigmoidf_(b); }
                        st16(HC + (size_t)row * 256 + 128 * (pn - 6) + 32 * wc + 8 * fq, o);
                    }
            } else {
#pragma unroll
                for (int ai = 0; ai < 2; ++ai)
#pragma unroll
                    for (int m = 0; m < 4; ++m) {
                        const int row = u.pm * 256 + ai * 128 + wr * 64 + m * 16 + fr;
                        const float rs = rsv[ai][m];
#pragma unroll
                        for (int bj = 0; bj < 2; ++bj) {
                            float o[8];
#pragma unroll
                            for (int n = 0; n < 2; ++n)
#pragma unroll
                                for (int j = 0; j < 4; ++j) o[4 * n + j] = acc[ai][bj][m][n][j] * rs;
                            st16(U + (size_t)row * 256 + 128 * bj + 32 * wc + 8 * fq, o);
                        }
                    }
            }
        } else {
            const int lay = u.pn >> 3, sub = u.pn & 7;
#pragma unroll
            for (int ai = 0; ai < 2; ++ai)
#pragma unroll
                for (int m = 0; m < 4; ++m) {
                    const int row = u.pm * 256 + ai * 128 + wr * 64 + m * 16 + fr;
                    if (sub < 4) {
#pragma unroll
                        for (int bj = 0; bj < 2; ++bj)
#pragma unroll
                            for (int n = 0; n < 2; ++n)
                                *(f32x4*)(kraw + ((size_t)lay * 512 + row) * 1024 + sub * 256 + 128 * bj + 32 * wc + 8 * fq + 4 * n) = acc[ai][bj][m][n];
                    } else {
                        const int b = row >> 8, mt = row & 255, head = sub - 4;
#pragma unroll
                        for (int bj = 0; bj < 2; ++bj)
#pragma unroll
                            for (int n = 0; n < 2; ++n)
#pragma unroll
                                for (int j = 0; j < 4; ++j) {
                                    const int d = 128 * bj + 32 * wc + 8 * fq + 4 * n + j;
                                    vtm[((size_t)((lay * 2 + b) * 4 + head) * 256 + d) * 256 + mt] = f2bf(acc[ai][bj][m][n][j]);
                                }
                    }
                }
        }
    }
};

struct EpiPwGlu {
    unsigned char* ws_; int l;
    __device__ __forceinline__ void operator()(const Acc& acc, const Unit& u, int wr, int wc, int fr, int fq) const {
        unsigned char* ws = launder(ws_);
        bf16_t* MIX = (bf16_t*)(ws + WS_MIX); float* ss_conv = SSP(l, SS_CONV);
#pragma unroll
        for (int ai = 0; ai < 2; ++ai)
#pragma unroll
            for (int m = 0; m < 4; ++m) {
                const int row = u.pm * 256 + ai * 128 + wr * 64 + m * 16 + fr;
                float ss = 0.f;
                if (u.prob == 0) {
#pragma unroll
                    for (int bj = 0; bj < 2; ++bj) {
                        float o[8];
#pragma unroll
                        for (int n = 0; n < 2; ++n)
#pragma unroll
                            for (int j = 0; j < 4; ++j) { o[4 * n + j] = acc[ai][bj][m][n][j]; ss += o[4 * n + j] * o[4 * n + j]; }
                        st16(MIX + (size_t)row * 1024 + 512 + 128 * bj + 32 * wc + 8 * fq, o);
                    }
                } else {
                    float o[8];
#pragma unroll
                    for (int n = 0; n < 2; ++n)
#pragma unroll
                        for (int j = 0; j < 4; ++j) { const float v = acc[ai][0][m][n][j] * sigmoidf_(acc[ai][1][m][n][j]); o[4 * n + j] = v; ss += v * v; }
                    st16(MIX + (size_t)row * 1024 + 768 + 128 * u.pn + 32 * wc + 8 * fq, o);
                }
                ss += xshfl<16>(ss); ss += xshfl<32>(ss);
                if (fq == 0) atomicAdd(ss_conv + (size_t)u.prob * M + row, ss);
            }
    }
};

struct EpiRes {
    float* xfinal; unsigned char* ws_; int ssidx;
    const LAS float* fac;
    __device__ __forceinline__ void operator()(const Acc& acc, const Unit& u, int wr, int wc, int fr, int fq) const {
        unsigned char* ws = launder(ws_);
        bf16_t* XB = (bf16_t*)(ws + WS_XB); float* ssn = ssidx >= 0 ? (float*)(ws + WS_SS) + (size_t)ssidx * M : nullptr;
#pragma unroll
        for (int ai = 0; ai < 2; ++ai) {
            u32x4 xh[4][2];
#pragma unroll
            for (int m = 0; m < 4; ++m) {
                const size_t off = (size_t)(u.pm * 256 + ai * 128 + wr * 64 + m * 16 + fr) * 1024 + u.pn * 256 + 32 * wc + 8 * fq;
#pragma unroll
                for (int bj = 0; bj < 2; ++bj) xh[m][bj] = *(const u32x4*)(XB + off + 128 * bj);
            }
#pragma unroll
            for (int m = 0; m < 4; ++m) {
                const int row = u.pm * 256 + ai * 128 + wr * 64 + m * 16 + fr;
                const float f3 = fac ? fac[(ai * 128 + wr * 64 + m * 16 + fr) * 4 + 2] : 1.f;
                float ss = 0.f;
#pragma unroll
                for (int bj = 0; bj < 2; ++bj) {
                    const size_t off = (size_t)row * 1024 + u.pn * 256 + 128 * bj + 32 * wc + 8 * fq;
                    float o[8];
#pragma unroll
                    for (int n = 0; n < 2; ++n)
#pragma unroll
                        for (int j = 0; j < 4; ++j) {
                            const int e = 4 * n + j; const unsigned wh = xh[m][bj][e >> 1];
                            const float v = ((e & 1) ? bfhi(wh) : bflo(wh)) + acc[ai][bj][m][n][j] * f3;
                            o[e] = v; ss += v * v;
                        }
                    if (xfinal) { *(f32x4*)(xfinal + off) = (f32x4){o[0], o[1], o[2], o[3]}; *(f32x4*)(xfinal + off + 4) = (f32x4){o[4], o[5], o[6], o[7]}; }
                    else st16(XB + off, o);
                }
                if (ssn) { ss += xshfl<16>(ss); ss += xshfl<32>(ss); if (fq == 0) atomicAdd(ssn + row, ss); }
            }
            asm volatile("" ::: "memory");
        }
    }
};

struct EpiQ {
    unsigned char* ws_; int l;
    __device__ __forceinline__ void operator()(const Acc& acc, const Unit& u, int wr, int wc, int fr, int fq) const {
        unsigned char* ws = launder(ws_);
        const float* ssx = SSP(l, SS_XA); bf16_t* XQ = (bf16_t*)(ws + WS_MIX);
        float rsv[2][4]; load_rs(rsv, ssx, u.pm * 256 + wr * 64 + fr);
#pragma unroll
        for (int ai = 0; ai < 2; ++ai)
#pragma unroll
            for (int m = 0; m < 4; ++m) {
                const int row = u.pm * 256 + ai * 128 + wr * 64 + m * 16 + fr;
                const float rs = rsv[ai][m];
                float ss = 0.f;
#pragma unroll
                for (int bj = 0; bj < 2; ++bj) {
                    float o[8];
#pragma unroll
                    for (int n = 0; n < 2; ++n)
#pragma unroll
                        for (int j = 0; j < 4; ++j) { o[4 * n + j] = acc[ai][bj][m][n][j] * rs; ss += o[4 * n + j] * o[4 * n + j]; }
                    st16(XQ + (size_t)row * 1024 + u.pn * 256 + 128 * bj + 32 * wc + 8 * fq, o);
                }
                ss += xshfl<16>(ss); ss += xshfl<32>(ss);
                if (fq == 0) atomicAdd((float*)(ws + WS_SSQ) + (size_t)(l * 4 + u.pn) * M + row, ss);
                asm volatile("" ::: "memory");
            }
    }
};

struct EpiFfn {
    unsigned char* ws_; int l;
    __device__ __forceinline__ void operator()(const Acc& acc, const Unit& u, int wr, int wc, int fr, int fq) const {
        unsigned char* ws = launder(ws_);
        const float* ssx = SSP(l, SS_FFN); bf16_t* HF = (bf16_t*)(ws + WS_HF);
        float rsv[2][4]; load_rs(rsv, ssx, u.pm * 256 + wr * 64 + fr);
#pragma unroll
        for (int ai = 0; ai < 2; ++ai)
#pragma unroll
            for (int m = 0; m < 4; ++m) {
                const int row = u.pm * 256 + ai * 128 + wr * 64 + m * 16 + fr;
                const float rs = rsv[ai][m];
                float o[8];
#pragma unroll
                for (int n = 0; n < 2; ++n)
#pragma unroll
                    for (int j = 0; j < 4; ++j) { const float g = acc[ai][0][m][n][j] * rs, up = acc[ai][1][m][n][j] * rs; o[4 * n + j] = g * sigmoidf_(g) * up; }
                st16_nt(HF + (size_t)row * FFH + 128 * u.pn + 32 * wc + 8 * fq, o);
            }
    }
};

constexpr int EX_OFF = 131072 + 4096;
struct EpiSm {
    unsigned char* ws_; int l; LAS unsigned char* lds;
    __device__ __forceinline__ void operator()(const Acc& acc, const Unit& u, int wr, int wc, int fr, int fq) const {
        unsigned char* ws = launder(ws_);
        const float* ssq = (const float*)(ws + WS_SSQ) + (size_t)(l * 4 + u.pn) * M;
        bf16_t* P = (bf16_t*)(ws + WS_HF);
        LAS float* EXm = (LAS float*)(lds + EX_OFF); LAS float* EXs = EXm + 1024;
        float rq[2][4], mx[2][4];
#pragma unroll
        for (int ai = 0; ai < 2; ++ai)
#pragma unroll
            for (int m = 0; m < 4; ++m) {
                const int rl = ai * 128 + wr * 64 + m * 16 + fr;
                rq[ai][m] = __builtin_amdgcn_rsqf(ssq[u.pm * 256 + rl] * (1.f / 256.f) + EPS) * (0.0625f * LOG2E);
                float v = -3.0e38f;
#pragma unroll
                for (int bj = 0; bj < 2; ++bj)
#pragma unroll
                    for (int n = 0; n < 2; ++n)
#pragma unroll
                        for (int j = 0; j < 4; ++j) v = fmaxf(v, acc[ai][bj][m][n][j]);
                v *= rq[ai][m];
                v = fmaxf(v, xshfl<16>(v)); v = fmaxf(v, xshfl<32>(v));
                if (fq == 0) EXm[rl * 4 + wc] = v;
            }
        asm volatile("s_waitcnt lgkmcnt(0)" ::: "memory"); __builtin_amdgcn_s_barrier(); asm volatile("" ::: "memory");
#pragma unroll
        for (int ai = 0; ai < 2; ++ai)
#pragma unroll
            for (int m = 0; m < 4; ++m) {
                const int rl = ai * 128 + wr * 64 + m * 16 + fr;
                const f32x4 e = *(const LAS f32x4*)(EXm + rl * 4);
                mx[ai][m] = fmaxf(fmaxf(e[0], e[1]), fmaxf(e[2], e[3]));
                float s = 0.f;
#pragma unroll
                for (int bj = 0; bj < 2; ++bj)
#pragma unroll
                    for (int n = 0; n < 2; ++n)
#pragma unroll
                        for (int j = 0; j < 4; ++j) s += ex2(acc[ai][bj][m][n][j] * rq[ai][m] - mx[ai][m]);
                s += xshfl<16>(s); s += xshfl<32>(s);
                if (fq == 0) EXs[rl * 4 + wc] = s;
            }
        asm volatile("s_waitcnt lgkmcnt(0)" ::: "memory"); __builtin_amdgcn_s_barrier(); asm volatile("" ::: "memory");
#pragma unroll
        for (int ai = 0; ai < 2; ++ai)
#pragma unroll
            for (int m = 0; m < 4; ++m) {
                const int rl = ai * 128 + wr * 64 + m * 16 + fr;
                const f32x4 e = *(const LAS f32x4*)(EXs + rl * 4);
                const float inv = __builtin_amdgcn_rcpf((e[0] + e[1]) + (e[2] + e[3]));
#pragma unroll
                for (int bj = 0; bj < 2; ++bj) {
                    float o[8];
#pragma unroll
                    for (int n = 0; n < 2; ++n)
#pragma unroll
                        for (int j = 0; j < 4; ++j) o[4 * n + j] = ex2(acc[ai][bj][m][n][j] * rq[ai][m] - mx[ai][m]) * inv;
                    st16(P + (size_t)(u.pm * 256 + rl) * 1024 + u.pn * 256 + 128 * bj + 32 * wc + 8 * fq, o);
                }
            }
    }
};
struct EpiPlain {
    unsigned char* ws_; size_t off;
    __device__ __forceinline__ void operator()(const Acc& acc, const Unit& u, int wr, int wc, int fr, int fq) const {
        bf16_t* O = (bf16_t*)(launder(ws_) + off);
#pragma unroll
        for (int ai = 0; ai < 2; ++ai)
#pragma unroll
            for (int m = 0; m < 4; ++m) {
                const int row = u.pm * 256 + ai * 128 + wr * 64 + m * 16 + fr;
#pragma unroll
                for (int bj = 0; bj < 2; ++bj) {
                    float o[8];
#pragma unroll
                    for (int n = 0; n < 2; ++n)
#pragma unroll
                        for (int j = 0; j < 4; ++j) o[4 * n + j] = acc[ai][bj][m][n][j];
                    st16(O + (size_t)row * 1024 + u.pn * 256 + 128 * bj + 32 * wc + 8 * fq, o);
                }
            }
    }
};

constexpr int XBST_OFF = 131072 + 512;
constexpr int ARGS_OFF = 131072 + 1024;
__device__ __forceinline__ unsigned char* argp(LAS unsigned char* lds, int i) {
    unsigned addr = (unsigned)(uintptr_t)(lds + ARGS_OFF) + 8u * (unsigned)i; asm volatile("" : "+s"(addr));
    const unsigned long long v = *(volatile LAS unsigned long long*)(uintptr_t)addr;
    const unsigned lo = __builtin_amdgcn_readfirstlane((unsigned)v), hi = __builtin_amdgcn_readfirstlane((unsigned)(v >> 32));
    return (unsigned char*)(GASP unsigned char*)(((unsigned long long)hi << 32) | lo);
}
#define AIN(k) ((const float*)argp(lds, (k)))
#define AOUT() ((float*)argp(lds, 33))

__device__ __forceinline__ void transpose_item(const float* W, int K, int Nsrc, bf16_t* WT, int dst_row0, int src_col0, int k0, const float* gain, LAS float* scr, int lane) {
    float wv[32];
#pragma unroll
    for (int i = 0; i < 32; ++i) wv[i] = W[(size_t)(k0 + 2 * i + (lane >> 5)) * Nsrc + src_col0 + (lane & 31)];
    if (gain) {
#pragma unroll
        for (int i = 0; i < 32; ++i) wv[i] *= gain[k0 + 2 * i + (lane >> 5)];
    }
#pragma unroll
    for (int i = 0; i < 32; ++i) scr[(2 * i + (lane >> 5)) * 33 + (lane & 31)] = wv[i];
    asm volatile("s_waitcnt lgkmcnt(0)" ::: "memory");
    const int c = lane & 7;
#pragma unroll
    for (int j = 0; j < 4; ++j) { const int n = (lane >> 3) + 8 * j; const LAS float* s = scr + (8 * c) * 33 + n;
        u32x4 o; o.x = cvt_pk_bf16(s[0 * 33], s[1 * 33]); o.y = cvt_pk_bf16(s[2 * 33], s[3 * 33]); o.z = cvt_pk_bf16(s[4 * 33], s[5 * 33]); o.w = cvt_pk_bf16(s[6 * 33], s[7 * 33]);
        *(u32x4*)(WT + (size_t)(dst_row0 + n) * K + k0 + 8 * c) = o; }
    asm volatile("s_waitcnt lgkmcnt(0)" ::: "memory");
}
__device__ __forceinline__ int colmap_in(int c) { const int pn = c >> 8, bj = (c >> 7) & 1, wc = (c >> 5) & 3;
    if (pn < 4) return 256 * pn + 64 * wc + 32 * bj;
    if (pn == 6 || pn == 7) return 1536 + 256 * bj + 128 * (pn - 6) + 32 * wc;
    return c; }
__device__ __forceinline__ int colmap_ffn(int c) { const int pn = c >> 8, bj = (c >> 7) & 1, wc = (c >> 5) & 3; return FFH * bj + 128 * pn + 32 * wc; }
__device__ __forceinline__ int colmap_glu(int c) { const int pn = c >> 8, bj = (c >> 7) & 1, wc = (c >> 5) & 3; return 256 * bj + 128 * pn + 32 * wc; }

struct KArgs { const float* in[33]; float* out; unsigned char* ws; };

__device__ __forceinline__ void transpose_job(int it, const float* W, int K, int Nsrc, int Ndst, bf16_t* WT, int dst_row_off, const float* gain, int mode, LAS float* scr, int lane) {
    const int nblk = Ndst / 32, kb = it / nblk, nb = it % nblk, n0 = 32 * nb;
    const int src = mode == 1 ? colmap_in(n0) : mode == 2 ? colmap_ffn(n0) : mode == 3 ? colmap_glu(n0) : n0;
    transpose_item(W, K, Nsrc, WT, dst_row_off + n0, src, 64 * kb, gain, scr, lane);
}

constexpr int CI_IN = (DM / 64) * (NIN / 32), CI_SQ = (DM / 64) * (DM / 32), CI_FFI = (DM / 64) * (2 * FFH / 32), CI_FFO = (FFH / 64) * (DM / 32), CI_PW2 = (256 / 64) * (256 / 32), CI_GLU = (256 / 64) * (512 / 32);
constexpr int CI_KV0 = CI_IN + 3 * CI_SQ, CI_KV1 = CI_IN + 5 * CI_SQ;
constexpr int CI_NIT = CI_IN + 5 * CI_SQ + CI_FFI + CI_FFO + CI_PW2 + CI_GLU, CI_DEFER = CI_NIT - 2 * CI_SQ;
__device__ __forceinline__ void convert_item(LAS unsigned char* lds, unsigned char* ws, int l, int it, LAS float* scr, int lane) {
    unsigned char* wl = ws + WS_W + (size_t)l * WL_STRIDE;
    int r = it;
    if (r < CI_IN) { transpose_job(r, AIN(3) + (size_t)l * DM * NIN, DM, NIN, NIN, (bf16_t*)(wl + WL_IN), 0, AIN(2) + l * DM, 1, scr, lane); return; } r -= CI_IN;
    if (r < CI_SQ) { transpose_job(r, AIN(21) + (size_t)l * DM * DM, DM, DM, DM, (bf16_t*)(wl + WL_OUT), 0, AIN(20) + l * DM, 0, scr, lane); return; } r -= CI_SQ;
    if (r < CI_SQ) { transpose_job(r, AIN(24) + (size_t)l * DM * DM, DM, DM, DM, (bf16_t*)(wl + WL_Q), 0, AIN(22) + l * DM, 0, scr, lane); return; } r -= CI_SQ;
    if (r < CI_SQ) { transpose_job(r, AIN(29) + (size_t)l * DM * DM, DM, DM, DM, (bf16_t*)(wl + WL_O), 0, nullptr, 0, scr, lane); return; } r -= CI_SQ;
    if (r < CI_SQ) { transpose_job(r, AIN(25) + (size_t)l * DM * DM, DM, DM, DM, (bf16_t*)(ws + WS_WKV) + (size_t)l * 2048 * 1024, 0, AIN(23) + l * DM, 0, scr, lane); return; } r -= CI_SQ;
    if (r < CI_SQ) { transpose_job(r, AIN(26) + (size_t)l * DM * DM, DM, DM, DM, (bf16_t*)(ws + WS_WKV) + (size_t)l * 2048 * 1024, 1024, AIN(23) + l * DM, 0, scr, lane); return; } r -= CI_SQ;
    if (r < CI_FFI) { transpose_job(r, AIN(31) + (size_t)l * DM * 2 * FFH, DM, 2 * FFH, 2 * FFH, (bf16_t*)(wl + WL_FFI), 0, AIN(30) + l * DM, 2, scr, lane); return; } r -= CI_FFI;
    if (r < CI_FFO) { transpose_job(r, AIN(32) + (size_t)l * FFH * DM, FFH, DM, DM, (bf16_t*)(wl + WL_FFO), 0, nullptr, 0, scr, lane); return; } r -= CI_FFO;
    if (r < CI_PW2) { transpose_job(r, AIN(10) + (size_t)l * 256 * 256, 256, 256, 256, (bf16_t*)(wl + WL_PW2), 0, nullptr, 0, scr, lane); return; } r -= CI_PW2;
    transpose_job(r, AIN(19) + (size_t)l * 256 * 512, 256, 512, 512, (bf16_t*)(wl + WL_GLU), 0, nullptr, 3, scr, lane);
}
constexpr int CI_D0 = CI_FFI + CI_FFO, CI_DTOT = CI_D0 + CI_DEFER, CI_DSPLIT = CI_D0 + 3000;
__device__ __forceinline__ void convert_deferred(LAS unsigned char* lds, unsigned char* ws, int d, LAS float* scr, int lane) {
    if (d < CI_D0) convert_item(lds, ws, 0, CI_KV1 + d, scr, lane);
    else { const int it = d - CI_D0; convert_item(lds, ws, 1, it < CI_KV0 ? it : it + 2 * CI_SQ, scr, lane); }
}
__device__ __forceinline__ void prologue(const KArgs& a, LAS unsigned char* lds, int gw, int NGW, int wave, int lane) {
    unsigned char* ws = a.ws;
    LAS float* scr = (LAS float*)(lds + wave * 16384);
    { float* ss = (float*)(ws + WS_SS); for (int i = gw * 64 + lane; i < 11 * M; i += NGW * 64) ss[M + i] = 0.f; }
    { float* sq = (float*)(ws + WS_SSQ); for (int i = gw * 64 + lane; i < 8 * M; i += NGW * 64) sq[i] = 0.f; }
    for (int it = gw; it < (CI_NIT - CI_D0) + 2 * CI_SQ; it += NGW) {
        if (it < CI_KV1) convert_item(lds, ws, 0, it, scr, lane);
        else if (it < CI_NIT - CI_D0) convert_item(lds, ws, 0, it + CI_D0, scr, lane);
        else convert_item(lds, ws, 1, CI_KV0 + (it - (CI_NIT - CI_D0)), scr, lane);
    }
    for (int r = gw; r < M + BATCH * NMEM; r += NGW) {
        const bool isx = r < M;
        const float* src = isx ? a.in[0] + (size_t)r * DM : a.in[1] + (size_t)(r - M) * DM;
        f32x4 v[4]; float s = 0.f;
#pragma unroll
        for (int j = 0; j < 4; ++j) { v[j] = *(const f32x4*)(src + 256 * j + 4 * lane); s += (v[j].x * v[j].x + v[j].y * v[j].y) + (v[j].z * v[j].z + v[j].w * v[j].w); }
        s = wave_sum(s);
        float sc = 1.f; bf16_t* dst;
        if (isx) { if (lane == 0) ((float*)(ws + WS_SS))[r] = s; dst = (bf16_t*)(ws + WS_XB) + (size_t)r * DM; }
        else { sc = __builtin_amdgcn_rsqf(s * (1.f / 1024.f) + EPS); dst = (bf16_t*)(ws + WS_HMN) + (size_t)(r - M) * DM; }
#pragma unroll
        for (int j = 0; j < 4; ++j) { u32x2 w; w.x = cvt_pk_bf16(v[j].x * sc, v[j].y * sc); w.y = cvt_pk_bf16(v[j].z * sc, v[j].w * sc); *(u32x2*)(dst + 256 * j + 4 * lane) = w; }
    }
}

__device__ __forceinline__ void sb_task(int task, const bf16_t* Q, const bf16_t* Kb, const bf16_t* Vt, bf16_t* MIX, float* ss_sb, int lane, bool do_atomic = true) {
    const int r32 = lane & 31, hi = lane >> 5;
    const int qb = task & 255, h = (task >> 8) & 7, b = task >> 11;
    const size_t rowbase = (size_t)b * SEQ; const int q0 = qb * 32;
    bf16x8 qf[4];
    { const bf16_t* qp = Q + (rowbase + q0 + r32) * 512 + h * 64 + hi * 8;
#pragma unroll
      for (int ks = 0; ks < 4; ++ks) qf[ks] = *(const bf16x8*)(qp + ks * 16); }
    f32x16 o0, o1;
#pragma unroll
    for (int r = 0; r < 16; ++r) { o0[r] = 0.f; o1[r] = 0.f; }
    float R = 0.f;
    const bf16_t* vt = Vt + (size_t)(b * 8 + h) * 64 * SEQ;
    for (int k0 = q0; k0 >= 0; k0 -= 32) {
        const bf16_t* kp = Kb + (rowbase + k0 + r32) * 512 + h * 64 + hi * 8;
        bf16x8 kf[4];
#pragma unroll
        for (int ks = 0; ks < 4; ++ks) kf[ks] = *(const bf16x8*)(kp + ks * 16);
        s16x4 vlo[2][2], vhi[2][2];
#pragma unroll
        for (int j = 0; j < 2; ++j)
#pragma unroll
            for (int db = 0; db < 2; ++db) { const bf16_t* vp = vt + (size_t)(32 * db + r32) * SEQ + k0 + 16 * j + 4 * hi; vlo[j][db] = *(const s16x4*)vp; vhi[j][db] = *(const s16x4*)(vp + 8); }
        f32x16 s;
#pragma unroll
        for (int r = 0; r < 16; ++r) s[r] = 0.f;
#pragma unroll
        for (int ks = 0; ks < 4; ++ks) s = MFMA32(kf[ks], qf[ks], s);
        const bool diag = (k0 == q0);
        float Lr[16];
#pragma unroll
        for (int r = 0; r < 16; ++r) {
            const float z = s[r];
            float Lv = fminf(-z, 0.f) - lg2(1.f + ex2(-fabsf(z)));
            if (diag && crow(r, hi) >= r32) Lv = 0.f;
            Lr[r] = Lv;
        }
        float tot[4], oth[4], pr[4];
#pragma unroll
        for (int G = 0; G < 4; ++G) { Lr[4 * G + 2] += Lr[4 * G + 3]; Lr[4 * G + 1] += Lr[4 * G + 2]; Lr[4 * G] += Lr[4 * G + 1]; tot[G] = Lr[4 * G]; }
#pragma unroll
        for (int G = 0; G < 4; ++G) { oth[G] = xshfl<32>(tot[G]); pr[G] = tot[G] + oth[G]; }
        float off[4];
        { const float sp3 = 0.f, sp2 = pr[3], sp1 = sp2 + pr[2], sp0 = sp1 + pr[1];
          off[3] = sp3 + R; off[2] = sp2 + R; off[1] = sp1 + R; off[0] = sp0 + R;
          if (hi == 0) { off[0] += oth[0]; off[1] += oth[1]; off[2] += oth[2]; off[3] += oth[3]; }
          R += sp0 + pr[0]; }
        float w[16];
#pragma unroll
        for (int r = 0; r < 16; ++r) { float wv = ex2(s[r] + Lr[r] + off[r >> 2]); if (diag && crow(r, hi) >= r32) wv = 0.f; w[r] = wv; }
        bf16x8 pa[2];
#pragma unroll
        for (int j = 0; j < 2; ++j) { u32x4 p; p.x = cvt_pk_bf16(w[8 * j], w[8 * j + 1]); p.y = cvt_pk_bf16(w[8 * j + 2], w[8 * j + 3]); p.z = cvt_pk_bf16(w[8 * j + 4], w[8 * j + 5]); p.w = cvt_pk_bf16(w[8 * j + 6], w[8 * j + 7]); pa[j] = __builtin_bit_cast(bf16x8, p); }
#pragma unroll
        for (int j = 0; j < 2; ++j) {
            const bf16x8 v0 = (bf16x8){vlo[j][0][0], vlo[j][0][1], vlo[j][0][2], vlo[j][0][3], vhi[j][0][0], vhi[j][0][1], vhi[j][0][2], vhi[j][0][3]};
            const bf16x8 v1 = (bf16x8){vlo[j][1][0], vlo[j][1][1], vlo[j][1][2], vlo[j][1][3], vhi[j][1][0], vhi[j][1][1], vhi[j][1][2], vhi[j][1][3]};
            o0 = MFMA32(pa[j], v0, o0); o1 = MFMA32(pa[j], v1, o1);
        }
        if (__all(R < -34.f)) break;
    }
#pragma unroll
    for (int r = 0; r < 16; ++r) {
        const size_t row = rowbase + q0 + crow(r, hi);
        MIX[row * 1024 + h * 64 + r32] = f2bf(o0[r]);
        MIX[row * 1024 + h * 64 + 32 + r32] = f2bf(o1[r]);
        float ss = o0[r] * o0[r] + o1[r] * o1[r];
        ss += xshfl<1>(ss); ss += xshfl<2>(ss); ss += xshfl<4>(ss); ss += xshfl<8>(ss); ss += xshfl<16>(ss);
        if (r32 == 0 && do_atomic) atomicAdd(ss_sb + row, ss);
    }
}

__device__ __forceinline__ void conv_task(int task, const bf16_t* HC, const LAS float* wlds, const float* dw_b, const float* ln_g, const float* ln_b, bf16_t* AC, int lane) {
    const int row0 = task * 4, t0 = row0 & (SEQ - 1);
    float acc[4][4];
    { const f32x4 bv = *(const f32x4*)(dw_b + 4 * lane);
#pragma unroll
      for (int tt = 0; tt < 4; ++tt) { acc[tt][0] = bv.x; acc[tt][1] = bv.y; acc[tt][2] = bv.z; acc[tt][3] = bv.w; } }
    u32x2 hv[34];
#pragma unroll
    for (int rr = 0; rr < 34; ++rr) {
        const int t = t0 - 30 + rr;
        u32x2 w = (u32x2){0u, 0u};
        if (t >= 0) w = *(const u32x2*)(HC + (size_t)(row0 - 30 + rr) * 256 + 4 * lane);
        hv[rr] = w;
    }
#pragma unroll
    for (int j = 0; j < 31; ++j) {
        const f32x4 wj = *(const LAS f32x4*)(wlds + j * 256 + 4 * lane);
#pragma unroll
        for (int tt = 0; tt < 4; ++tt) {
            const u32x2 w = hv[tt + j];
            acc[tt][0] += wj.x * bflo(w.x); acc[tt][1] += wj.y * bfhi(w.x); acc[tt][2] += wj.z * bflo(w.y); acc[tt][3] += wj.w * bfhi(w.y);
        }
    }
    const f32x4 gv = *(const f32x4*)(ln_g + 4 * lane), bv2 = *(const f32x4*)(ln_b + 4 * lane);
#pragma unroll
    for (int tt = 0; tt < 4; ++tt) {
        const float mean = wave_sum((acc[tt][0] + acc[tt][1]) + (acc[tt][2] + acc[tt][3])) * (1.f / 256.f);
        const float d0 = acc[tt][0] - mean, d1 = acc[tt][1] - mean, d2 = acc[tt][2] - mean, d3 = acc[tt][3] - mean;
        const float var = wave_sum((d0 * d0 + d1 * d1) + (d2 * d2 + d3 * d3)) * (1.f / 256.f);
        const float rstd = __builtin_amdgcn_rsqf(var + EPS);
        float y0 = d0 * rstd * gv.x + bv2.x, y1 = d1 * rstd * gv.y + bv2.y, y2 = d2 * rstd * gv.z + bv2.z, y3 = d3 * rstd * gv.w + bv2.w;
        y0 *= sigmoidf_(y0); y1 *= sigmoidf_(y1); y2 *= sigmoidf_(y2); y3 *= sigmoidf_(y3);
        u32x2 w; w.x = cvt_pk_bf16(y0, y1); w.y = cvt_pk_bf16(y2, y3);
        *(u32x2*)(AC + (size_t)(row0 + tt) * 256 + 4 * lane) = w;
    }
}

struct SsmW { const float *lam_re, *lam_im, *log_dt, *b_re, *b_im, *c_re, *c_im, *dsk; };
__device__ __forceinline__ u32x4 pack8(const float* v) { u32x4 w; w.x = cvt_pk_bf16(v[0], v[1]); w.y = cvt_pk_bf16(v[2], v[3]); w.z = cvt_pk_bf16(v[4], v[5]); w.w = cvt_pk_bf16(v[6], v[7]); return w; }
template <bool PASSC>
__device__ __forceinline__ void ssm_task(int task, const SsmW& W, const bf16_t* U, f32x2* SST, bf16_t* YS, LAS unsigned char* wl, int lane) {
    const int g = (task >> 7) & 15, b = task >> 11;
    const int c = b ? 127 - (task & 127) : (task & 127);
    const size_t tok0 = (size_t)b * SEQ + c * 64;
    LAS unsigned char* BU = wl;
    LAS unsigned char* xb = wl + 8320;
    const int hh = lane & 15, kq = lane >> 4;
    const float lr = W.lam_re[g * 64 + lane], li = W.lam_im[g * 64 + lane], dt = __expf(W.log_dt[g]);
    const float mag = __expf(lr * dt);
    float sn, cs; { const float ang = li * dt; const float kk = rintf(ang * 0.15915494309189535f); float rr = fmaf(-kk, 6.28125f, ang); rr = fmaf(-kk, 1.9353071795864769e-3f, rr); sn = __sinf(rr); cs = __cosf(rr); }
    const float ar = mag * cs, ai = mag * sn;
    const float den = lr * lr + li * li;
    const float fr = ((ar - 1.f) * lr + ai * li) / den, fi = (ai * lr - (ar - 1.f) * li) / den;
    {
        float bbr[16], bbi[16];
        const f32x4* brp = (const f32x4*)(W.b_re + (size_t)(g * 64 + lane) * 16); const f32x4* bip = (const f32x4*)(W.b_im + (size_t)(g * 64 + lane) * 16);
#pragma unroll
        for (int q = 0; q < 4; ++q) { const f32x4 br = brp[q], bi = bip[q];
#pragma unroll
            for (int j = 0; j < 4; ++j) { bbr[4 * q + j] = fr * br[j] - fi * bi[j]; bbi[4 * q + j] = fr * bi[j] + fi * br[j]; } }
        LAS u32x4* t = (LAS u32x4*)(BU + lane * 64);
        t[0] = pack8(bbr); t[1] = pack8(bbr + 8); t[2] = pack8(bbi); t[3] = pack8(bbi + 8);
    }
    asm volatile("s_waitcnt lgkmcnt(0)" ::: "memory");
    const bf16x8 zfrag = (bf16x8){0, 0, 0, 0, 0, 0, 0, 0};
    bf16x8 bfr[8];
#pragma unroll
    for (int nb = 0; nb < 8; ++nb) bfr[nb] = (kq < 2) ? *(const LAS bf16x8*)(BU + (16 * nb + hh) * 32 + kq * 16) : zfrag;
    bf16x8 cf[4];
    if (PASSC) {
#pragma unroll
        for (int ks = 0; ks < 4; ++ks) {
            const int p0 = 16 * ks + 4 * kq;
            const f32x4 cre = *(const f32x4*)(W.c_re + (size_t)(g * 16 + hh) * 64 + p0), cim = *(const f32x4*)(W.c_im + (size_t)(g * 16 + hh) * 64 + p0);
            u32x4 cw; cw.x = cvt_pk_bf16(cre[0], -cim[0]); cw.y = cvt_pk_bf16(cre[1], -cim[1]); cw.z = cvt_pk_bf16(cre[2], -cim[2]); cw.w = cvt_pk_bf16(cre[3], -cim[3]);
            cf[ks] = __builtin_bit_cast(bf16x8, cw);
        }
    }
    float xr = 0.f, xi = 0.f;
    if (PASSC) {
        float tr = ar, ti = ai;
#pragma unroll
        for (int i = 0; i < 6; ++i) { const float nr = tr * tr - ti * ti, ni = 2.f * tr * ti; tr = nr; ti = ni; }
        const f32x2* sp = SST + ((size_t)(b * 16 + g) * 128) * 64 + lane;
        for (int j0 = 0; j0 < c; j0 += 16) {
            f32x2 sv[16];
#pragma unroll
            for (int q = 0; q < 16; ++q) sv[q] = (j0 + q < c) ? sp[(size_t)(j0 + q) * 64] : (f32x2){0.f, 0.f};
#pragma unroll
            for (int q = 0; q < 16; ++q) if (j0 + q < c) { const float nr = tr * xr - ti * xi + sv[q].x, ni = tr * xi + ti * xr + sv[q].y; xr = nr; xi = ni; }
        }
    }
    const float dk = PASSC ? W.dsk[g * 16 + hh] : 0.f;
    asm volatile("s_waitcnt lgkmcnt(0)" ::: "memory");
#pragma unroll 1
    for (int blk = 0; blk < 4; ++blk) {
        const bf16_t* ub = U + (tok0 + blk * 16) * 256 + g * 16;
        bf16x8 af = zfrag;
        if (kq < 2) af = *(const bf16x8*)(ub + (size_t)hh * 256 + kq * 8);
#pragma unroll
        for (int nb = 0; nb < 8; ++nb) {
            const f32x4 d = MFMA16(af, bfr[nb], ((f32x4){0.f, 0.f, 0.f, 0.f}));
#pragma unroll
            for (int i = 0; i < 4; ++i) *(LAS float*)(BU + (4 * kq + i) * 520 + (16 * nb + hh) * 4) = d[i];
        }
        asm volatile("s_waitcnt lgkmcnt(0)" ::: "memory");
#pragma unroll
        for (int s = 0; s < 16; ++s) {
            const f32x2 bu = *(const LAS f32x2*)(BU + s * 520 + 8 * lane);
            const float nr = ar * xr - ai * xi + bu.x, ni = ar * xi + ai * xr + bu.y; xr = nr; xi = ni;
            if (PASSC) *(LAS unsigned*)(xb + s * 272 + 4 * lane) = cvt_pk_bf16(xr, xi);
        }
        if (PASSC) {
            asm volatile("s_waitcnt lgkmcnt(0)" ::: "memory");
            f32x4 y = (f32x4){0.f, 0.f, 0.f, 0.f};
#pragma unroll
            for (int ks = 0; ks < 4; ++ks) { const bf16x8 a0 = *(const LAS bf16x8*)(xb + hh * 272 + 64 * ks + 16 * kq); y = MFMA16(a0, cf[ks], y); }
#pragma unroll
            for (int i = 0; i < 4; ++i) {
                const size_t e = (size_t)(4 * kq + i) * 256 + hh;
                YS[(tok0 + blk * 16) * 256 + g * 16 + e] = f2bf(y[i] + dk * bf2f(ub[e]));
            }
        }
        asm volatile("s_waitcnt lgkmcnt(0)" ::: "memory");
    }
    if (!PASSC) SST[((size_t)(b * 16 + g) * 128 + c) * 64 + lane] = (f32x2){xr, xi};
}

template <bool PASSC>
__device__ __forceinline__ void ssm_task_old(int task, const SsmW& W, const bf16_t* U, f32x2* SST, bf16_t* YS, LAS unsigned char* wl, int lane) {
    const int c = task & 127, g = (task >> 7) & 15, b = task >> 11;
    const size_t tok0 = (size_t)b * SEQ + c * 64;
    LAS float* uL = (LAS float*)wl;
    LAS unsigned char* xb = wl + 4096;
    {
        const u32x4* up = (const u32x4*)(U + (tok0 + lane) * 256 + g * 16);
        const u32x4 w0 = up[0], w1 = up[1];
        LAS f32x4* d = (LAS f32x4*)(uL + lane * 16);
        d[0] = (f32x4){bflo(w0.x), bfhi(w0.x), bflo(w0.y), bfhi(w0.y)}; d[1] = (f32x4){bflo(w0.z), bfhi(w0.z), bflo(w0.w), bfhi(w0.w)};
        d[2] = (f32x4){bflo(w1.x), bfhi(w1.x), bflo(w1.y), bfhi(w1.y)}; d[3] = (f32x4){bflo(w1.z), bfhi(w1.z), bflo(w1.w), bfhi(w1.w)};
    }
    const float lr = W.lam_re[g * 64 + lane], li = W.lam_im[g * 64 + lane], dt = __expf(W.log_dt[g]);
    const float mag = __expf(lr * dt);
    float sn, cs; { const float ang = li * dt; const float kq = rintf(ang * 0.15915494309189535f); float rr = fmaf(-kq, 6.28125f, ang); rr = fmaf(-kq, 1.9353071795864769e-3f, rr); sn = __sinf(rr); cs = __cosf(rr); }
    const float ar = mag * cs, ai = mag * sn;
    const float den = lr * lr + li * li;
    const float fr = ((ar - 1.f) * lr + ai * li) / den, fi = (ai * lr - (ar - 1.f) * li) / den;
    float bbr[16], bbi[16];
    { const f32x4* brp = (const f32x4*)(W.b_re + (size_t)(g * 64 + lane) * 16); const f32x4* bip = (const f32x4*)(W.b_im + (size_t)(g * 64 + lane) * 16);
#pragma unroll
      for (int q = 0; q < 4; ++q) { const f32x4 br = brp[q], bi = bip[q];
#pragma unroll
          for (int j = 0; j < 4; ++j) { bbr[4 * q + j] = fr * br[j] - fi * bi[j]; bbi[4 * q + j] = fr * bi[j] + fi * br[j]; } } }
    float xr = 0.f, xi = 0.f;
    if (PASSC) {
        float tr = ar, ti = ai;
#pragma unroll
        for (int i = 0; i < 6; ++i) { const float nr = tr * tr - ti * ti, ni = 2.f * tr * ti; tr = nr; ti = ni; }
        const f32x2* sp = SST + ((size_t)(b * 16 + g) * 128) * 64 + lane;
        for (int j0 = 0; j0 < c; j0 += 16) {
            f32x2 sv[16];
#pragma unroll
            for (int q = 0; q < 16; ++q) sv[q] = (j0 + q < c) ? sp[(size_t)(j0 + q) * 64] : (f32x2){0.f, 0.f};
#pragma unroll
            for (int q = 0; q < 16; ++q) if (j0 + q < c) { const float nr = tr * xr - ti * xi + sv[q].x, ni = tr * xi + ti * xr + sv[q].y; xr = nr; xi = ni; }
        }
    }
    asm volatile("s_waitcnt lgkmcnt(0)" ::: "memory");
#pragma unroll 1
    for (int half = 0; half < 2; ++half) {
#pragma unroll 4
        for (int s = 0; s < 32; ++s) {
            const LAS f32x4* ur = (const LAS f32x4*)(uL + (half * 32 + s) * 16);
            float br_ = 0.f, bi_ = 0.f;
#pragma unroll
            for (int q = 0; q < 4; ++q) { const f32x4 uv = ur[q];
#pragma unroll
                for (int j = 0; j < 4; ++j) { br_ = fmaf(bbr[4 * q + j], uv[j], br_); bi_ = fmaf(bbi[4 * q + j], uv[j], bi_); } }
            const float nr = ar * xr - ai * xi + br_, ni = ar * xi + ai * xr + bi_; xr = nr; xi = ni;
            if (PASSC) *(LAS unsigned*)(xb + s * 272 + 4 * lane) = cvt_pk_bf16(xr, xi);
        }
        if (PASSC) {
            asm volatile("s_waitcnt lgkmcnt(0)" ::: "memory");
            const int hh = lane & 15, kq = lane >> 4;
            f32x4 y0 = (f32x4){0.f, 0.f, 0.f, 0.f}, y1 = y0;
#pragma unroll
            for (int ks = 0; ks < 4; ++ks) {
                const int p0 = 16 * ks + 4 * kq;
                const f32x4 cre = *(const f32x4*)(W.c_re + (size_t)(g * 16 + hh) * 64 + p0), cim = *(const f32x4*)(W.c_im + (size_t)(g * 16 + hh) * 64 + p0);
                u32x4 cw; cw.x = cvt_pk_bf16(cre[0], -cim[0]); cw.y = cvt_pk_bf16(cre[1], -cim[1]); cw.z = cvt_pk_bf16(cre[2], -cim[2]); cw.w = cvt_pk_bf16(cre[3], -cim[3]);
                const bf16x8 cf = __builtin_bit_cast(bf16x8, cw);
                const bf16x8 a0 = *(const LAS bf16x8*)(xb + (lane & 15) * 272 + 64 * ks + 16 * kq);
                const bf16x8 a1 = *(const LAS bf16x8*)(xb + (16 + (lane & 15)) * 272 + 64 * ks + 16 * kq);
                y0 = MFMA16(a0, cf, y0); y1 = MFMA16(a1, cf, y1);
            }
            const float dk = W.dsk[g * 16 + hh];
#pragma unroll
            for (int i = 0; i < 4; ++i) {
                const int s0 = 4 * kq + i, s1 = 16 + 4 * kq + i;
                const float v0 = y0[i] + dk * uL[(half * 32 + s0) * 16 + hh], v1 = y1[i] + dk * uL[(half * 32 + s1) * 16 + hh];
                YS[(tok0 + half * 32 + s0) * 256 + g * 16 + hh] = f2bf(v0);
                YS[(tok0 + half * 32 + s1) * 256 + g * 16 + hh] = f2bf(v1);
            }
            asm volatile("s_waitcnt lgkmcnt(0)" ::: "memory");
        }
    }
    if (!PASSC) SST[((size_t)(b * 16 + g) * 128 + c) * 64 + lane] = (f32x2){xr, xi};
}

__device__ __forceinline__ void knorm_task(int task, const float* kraw, const float* kg_all, const float* qg_all, bf16_t* KP, int lane) {
    const int head = task & 3, row = (task >> 2) & 511, lay = task >> 11;
    const f32x4 v = *(const f32x4*)(kraw + ((size_t)lay * 512 + row) * 1024 + head * 256 + 4 * lane);
    const float ss = wave_sum((v.x * v.x + v.y * v.y) + (v.z * v.z + v.w * v.w));
    const float rs = __builtin_amdgcn_rsqf(ss * (1.f / 256.f) + EPS);
    const f32x4 kg = *(const f32x4*)(kg_all + lay * 256 + 4 * lane), qg = *(const f32x4*)(qg_all + lay * 256 + 4 * lane);
    const int b = row >> 8, mt = row & 255;
    u32x2 w; w.x = cvt_pk_bf16(v.x * rs * kg.x * qg.x, v.y * rs * kg.y * qg.y); w.y = cvt_pk_bf16(v.z * rs * kg.z * qg.z, v.w * rs * kg.w * qg.w);
    *(u32x2*)(KP + ((size_t)((lay * 2 + b) * 4 + head) * 256 + mt) * 256 + 4 * lane) = w;
}

__device__ __forceinline__ void xa_task(int task, const bf16_t* XQ, const bf16_t* KPl, const bf16_t* VTMl, bf16_t* XO, int lane) {
    const int r32 = lane & 31, hi = lane >> 5;
    const int qb = task & 255, head = (task >> 8) & 3, b = task >> 10;
    const size_t rowbase = (size_t)b * SEQ; const int q0 = qb * 32;
    float ssq = 0.f;
    const bf16_t* qp = XQ + (rowbase + q0 + r32) * 1024 + head * 256 + hi * 8;
#pragma unroll
    for (int ks = 0; ks < 16; ++ks) { const bf16x8 qv = *(const bf16x8*)(qp + ks * 16);
#pragma unroll
        for (int j = 0; j < 8; ++j) { const float f = bf2f((unsigned short)qv[j]); ssq += f * f; } }
    ssq += xshfl<32>(ssq);
    const float rq = __builtin_amdgcn_rsqf(ssq * (1.f / 256.f) + EPS) * (0.0625f * LOG2E);
    const bf16_t* kbase = KPl + ((size_t)(b * 4 + head) * 256 + r32) * 256 + hi * 8;
    f32x16 sc[8];
#pragma unroll
    for (int kb = 0; kb < 8; ++kb) {
        f32x16 s;
#pragma unroll
        for (int r = 0; r < 16; ++r) s[r] = 0.f;
#pragma unroll
        for (int ks = 0; ks < 16; ++ks) { const bf16x8 kf = *(const bf16x8*)(kbase + (size_t)kb * 32 * 256 + ks * 16); const bf16x8 qv = *(const bf16x8*)(qp + ks * 16); s = MFMA32(kf, qv, s); }
        sc[kb] = s * rq;
        asm volatile("" ::: "memory");
    }
    float mx = -3.0e38f;
#pragma unroll
    for (int kb = 0; kb < 8; ++kb)
#pragma unroll
        for (int r = 0; r < 16; ++r) mx = fmaxf(mx, sc[kb][r]);
    mx = fmaxf(mx, xshfl<32>(mx));
    float sum = 0.f;
#pragma unroll
    for (int kb = 0; kb < 8; ++kb)
#pragma unroll
        for (int r = 0; r < 16; ++r) { const float p = ex2(sc[kb][r] - mx); sc[kb][r] = p; sum += p; }
    sum += xshfl<32>(sum);
    const float inv = __builtin_amdgcn_rcpf(sum);
    bf16x8 pa[8][2];
#pragma unroll
    for (int kb = 0; kb < 8; ++kb)
#pragma unroll
        for (int j = 0; j < 2; ++j) { u32x4 p; p.x = cvt_pk_bf16(sc[kb][8 * j] * inv, sc[kb][8 * j + 1] * inv); p.y = cvt_pk_bf16(sc[kb][8 * j + 2] * inv, sc[kb][8 * j + 3] * inv);
            p.z = cvt_pk_bf16(sc[kb][8 * j + 4] * inv, sc[kb][8 * j + 5] * inv); p.w = cvt_pk_bf16(sc[kb][8 * j + 6] * inv, sc[kb][8 * j + 7] * inv); pa[kb][j] = __builtin_bit_cast(bf16x8, p); }
    const bf16_t* vbase = VTMl + ((size_t)(b * 4 + head) * 256 + r32) * 256 + 4 * hi;
#pragma unroll 1
    for (int db = 0; db < 8; ++db) {
        f32x16 o;
#pragma unroll
        for (int r = 0; r < 16; ++r) o[r] = 0.f;
        const bf16_t* vp = vbase + (size_t)db * 32 * 256;
#pragma unroll
        for (int kb = 0; kb < 8; ++kb)
#pragma unroll
            for (int j = 0; j < 2; ++j) {
                const s16x4 lo = *(const s16x4*)(vp + kb * 32 + 16 * j), hi4 = *(const s16x4*)(vp + kb * 32 + 16 * j + 8);
                const bf16x8 vf = (bf16x8){lo[0], lo[1], lo[2], lo[3], hi4[0], hi4[1], hi4[2], hi4[3]};
                o = MFMA32(pa[kb][j], vf, o);
            }
#pragma unroll
        for (int r = 0; r < 16; ++r) XO[(rowbase + q0 + crow(r, hi)) * 1024 + head * 256 + db * 32 + r32] = f2bf(o[r]);
    }
}

#define XB_TMO      128
#define XB_XCNT(j)  (256  + 64 * (j))
#define XB_XSUB(j)  (1280 + 64 * (j))
#define XB_XGEN(j)  (2304 + 64 * (j))
#define XB_TOP      3328
#define XB_TOPGEN   3392
#define XCD_BAR_WORDS 3456
#define XB_SPIN_CAP (1u << 18)

__device__ __forceinline__ unsigned xb_ld(unsigned* p)              { return __hip_atomic_load(p, __ATOMIC_RELAXED, __HIP_MEMORY_SCOPE_AGENT); }
__device__ __forceinline__ unsigned xb_add(unsigned* p, unsigned v) { return __hip_atomic_fetch_add(p, v, __ATOMIC_RELAXED, __HIP_MEMORY_SCOPE_AGENT); }
__device__ __forceinline__ unsigned xb_xcc_id() { return (unsigned)__builtin_amdgcn_s_getreg((3 << 11) | 20) & 0xFu; }
#define XB_SPIN(cond, bar) do { unsigned _sp = 0; while (cond) { __builtin_amdgcn_s_sleep(1); \
    if ((++_sp & 255u) == 0u) { if (xb_ld(&(bar)[XB_TMO])) break; if (_sp > XB_SPIN_CAP) { atomicAdd(&(bar)[XB_TMO], 1u); break; } } } } while (0)

struct XcdBarrier {
    unsigned* bar; unsigned x;
    volatile LAS unsigned* st;
};

__device__ __forceinline__ XcdBarrier xcd_barrier_post(unsigned* bar, volatile LAS unsigned* st) {
    XcdBarrier b; b.bar = bar; b.x = xb_xcc_id(); b.st = st;
    if (threadIdx.x == 0) (void)xb_add(&bar[XB_XCNT(b.x)], 1u);
    return b;
}
__device__ __forceinline__ void xcd_barrier_complete(unsigned* bar, unsigned x, unsigned& nloc, unsigned& nx) {
    const unsigned G = gridDim.x * gridDim.y * gridDim.z;
    unsigned sum, cnt, mine, sp = 0u;
    for (;;) {
        sum = 0u; cnt = 0u; mine = 0u;
#pragma unroll
        for (unsigned j = 0; j < 16; ++j) { const unsigned c = xb_ld(&bar[XB_XCNT(j)]); sum += c; cnt += (c > 0u) ? 1u : 0u; mine = (j == x) ? c : mine; }
        if (sum == G) break;
        __builtin_amdgcn_s_sleep(1);
        if ((++sp & 255u) == 0u) { if (xb_ld(&bar[XB_TMO])) break; if (sp > XB_SPIN_CAP) { atomicAdd(&bar[XB_TMO], 1u); break; } }
    }
    nloc = mine > 0u ? mine : 1u; nx = cnt > 0u ? cnt : 1u;
}

__device__ __forceinline__ void xcd_barrier(const XcdBarrier& b) {
    asm volatile("s_waitcnt vmcnt(0)" ::: "memory");
    __syncthreads();
    if (threadIdx.x == 0) {
        unsigned* bar = b.bar;
        __builtin_amdgcn_s_waitcnt(0);
        unsigned nloc = b.st[0], nx = b.st[1];
        if (nloc == 0u) { xcd_barrier_complete(bar, b.x, nloc, nx); b.st[0] = nloc; b.st[1] = nx; }
        const unsigned old = xb_add(&bar[XB_XSUB(b.x)], 1u);
        const unsigned gen = old / nloc;
        if (old + 1u == (gen + 1u) * nloc) {
            __builtin_amdgcn_fence(__ATOMIC_RELEASE, "agent");
            asm volatile("s_waitcnt vmcnt(0)" ::: "memory");
            const unsigned og = xb_add(&bar[XB_TOP], 1u);
            const unsigned tg = og / nx;
            if (og + 1u == (tg + 1u) * nx) xb_add(&bar[XB_TOPGEN], 1u);
            else XB_SPIN(xb_ld(&bar[XB_TOPGEN]) == tg, bar);
            __builtin_amdgcn_fence(__ATOMIC_ACQUIRE, "agent");
            xb_add(&bar[XB_XGEN(b.x)], 1u);
            asm volatile("s_waitcnt vmcnt(0)" ::: "memory");
        } else {
            XB_SPIN(xb_ld(&bar[XB_XGEN(b.x)]) == gen, bar);
            __builtin_amdgcn_fence(__ATOMIC_ACQUIRE, "agent");
            asm volatile("s_waitcnt vmcnt(0)" ::: "memory");
        }
    }
    __syncthreads();
}


#ifndef REP_SYNC
#define REP_SYNC 0
#endif
#ifndef REP_PRO
#define REP_PRO 0
#endif
#ifndef REP_XA
#define REP_XA 0
#endif
#ifndef REP_SB
#define REP_SB 0
#endif
#ifndef REP_CONV
#define REP_CONV 0
#endif
#ifndef REP_SSMA
#define REP_SSMA 0
#endif
#ifndef REP_PA
#define REP_PA 0
#endif
#ifndef REP_PJ
#define REP_PJ 0
#endif
#ifndef REP_PC
#define REP_PC 0
#endif
#define GSYNC() do { xcd_barrier(xbar); for (int r_ = 0; r_ < REP_SYNC; ++r_) xcd_barrier(xbar); } while (0)
__global__ void __launch_bounds__(NWAVES * 64, 2) fwd_kernel(KArgs a) {
    extern __shared__ __attribute__((aligned(16))) unsigned char lds_raw[];
    LAS unsigned char* lds = (LAS unsigned char*)lds_raw;
    cg::grid_group grid = cg::this_grid();
    const int wave = __builtin_amdgcn_readfirstlane((int)threadIdx.x >> 6);
    const int G = gridDim.x, vcu = (G % 8 == 0) ? ((int)blockIdx.x % 8) * (G / 8) + (int)blockIdx.x / 8 : (int)blockIdx.x;
    const int gw = vcu * NWAVES + wave, NGW = G * NWAVES;
#define PHASE_PTRS() unsigned char* ws = argp(lds, 34); const int ln = lane_id_asm(); int gwl = launder_i(gw); (void)ln; (void)gwl; unsigned char* wl = ws + WS_W + (size_t)l * WL_STRIDE; (void)wl; \
    bf16_t* XB = (bf16_t*)(ws + WS_XB); bf16_t* Qb = (bf16_t*)(ws + WS_Q); bf16_t* Kb = (bf16_t*)(ws + WS_K); bf16_t* Vt = (bf16_t*)(ws + WS_VT); \
    bf16_t* HC = (bf16_t*)(ws + WS_HC); bf16_t* Ub = (bf16_t*)(ws + WS_U); bf16_t* AC = (bf16_t*)(ws + WS_AC); bf16_t* YS = (bf16_t*)(ws + WS_YS); \
    float* KRAW = (float*)(ws + WS_KRAW); bf16_t* HF = (bf16_t*)(ws + WS_HF); bf16_t* MIX = (bf16_t*)(ws + WS_MIX); bf16_t* XO = (bf16_t*)AOUT(); \
    f32x2* SST = (f32x2*)(ws + WS_SST); bf16_t* KP = (bf16_t*)(ws + WS_KP); bf16_t* VTM = (bf16_t*)(ws + WS_VTM); bf16_t* HMN = (bf16_t*)(ws + WS_HMN); \
    (void)XB; (void)Qb; (void)Kb; (void)Vt; (void)HC; (void)Ub; (void)AC; (void)YS; (void)KRAW; (void)HF; (void)MIX; (void)XO; (void)SST; (void)KP; (void)VTM; (void)HMN;

    if (threadIdx.x < 2) ((volatile LAS unsigned*)(lds + XBST_OFF))[threadIdx.x] = 0u;
    __syncthreads();
    XcdBarrier xbar = xcd_barrier_post((unsigned*)(a.ws + WS_BAR), (volatile LAS unsigned*)(lds + XBST_OFF));
    if (threadIdx.x == 0) {
        volatile LAS unsigned long long* ap = (volatile LAS unsigned long long*)(lds + ARGS_OFF);
#pragma unroll
        for (int i = 0; i < 33; ++i) ap[i] = (unsigned long long)a.in[i];
        ap[33] = (unsigned long long)a.out; ap[34] = (unsigned long long)a.ws;
    }
#ifndef SKIP_PRO
    __syncthreads();
    for (int r_ = 0; r_ <= REP_PRO; ++r_) prologue(a, lds, gw, NGW, wave, lane_id_asm());
#endif
    __syncthreads();
    if (a.ws == nullptr) grid.sync();
    GSYNC();

    for (int l = 0; l < DEPTH; ++l) {
        {
            PHASE_PTRS();
            pg8::Sched S; S.A0 = (const char*)XB; S.B0 = (const char*)(wl + WL_IN); S.nM0 = M / 256; S.nN0 = NIN / 256;
            S.A1 = (const char*)HMN; S.B1 = (const char*)(ws + WS_WKV); S.nM1 = 2; S.nN1 = 16; S.np = (l == 0) ? 2 : 1; S.K = DM; S.G = G; S.c = launder_i(blockIdx.x);
            EpiIn E{ws, l, AIN(4) + l * 64, AIN(5) + l * 64};
#if !defined(SKIP_GEMM) && (!defined(GSEL) || (GSEL & 1))
            for (int r_ = 0; r_ < REP_PA; ++r_) pg8::gemm_phase(lds, S, E, wave);
            pg8::gemm_phase(lds, S, E, wave);
#endif
            if (l == 0) {
                const int first = (G > 96) ? 96 : 0, nb = G - first;
                if ((int)blockIdx.x >= first) {
                    const int ln5 = lane_id_asm(); LAS float* scr = (LAS float*)(lds + wave * 16384);
                    for (int d = ((int)blockIdx.x - first) * NWAVES + wave; d < CI_DSPLIT; d += nb * NWAVES) convert_deferred(lds, ws, d, scr, ln5);
                }
            }
        }
        GSYNC();
        {
            PHASE_PTRS();
            #ifndef SKIP_SB
            { const float* dw = AIN(6) + l * 31 * 256; const int tl = wave * 64 + ln;
              for (int i = tl; i < 31 * 64; i += NWAVES * 64) ((LAS f32x4*)lds)[i] = ((const f32x4*)dw)[i];
              __syncthreads(); }
            for (int r_ = 0; r_ <= REP_SB; ++r_) { const int ln1 = lane_id_asm(); for (int t = gwl; t < 4096; t += NGW) sb_task(t, Qb, Kb, Vt, MIX, SSP(l, SS_SB), ln1, r_ == 0); }
#endif
#ifndef SKIP_CONV
            for (int r_ = 0; r_ <= REP_CONV; ++r_) { const int ln2 = lane_id_asm(); for (int t = gwl; t < M / 4; t += NGW) conv_task(t, HC, (const LAS float*)lds, AIN(7) + l * 256, AIN(8) + l * 256, AIN(9) + l * 256, AC, ln2); }
#endif
            __syncthreads();
            SsmW W{AIN(11) + l * 1024, AIN(12) + l * 1024, AIN(13) + l * 16, AIN(14) + (size_t)l * 16384, AIN(15) + (size_t)l * 16384, AIN(16) + (size_t)l * 16384, AIN(17) + (size_t)l * 16384, AIN(18) + l * 256};
#ifndef SKIP_SSM
            for (int r_ = 0; r_ <= REP_SSMA; ++r_) { const int ln3 = lane_id_asm(); for (int t = gwl; t < 4096; t += NGW) ssm_task_old<false>(t, W, Ub, SST, YS, lds + wave * 16384, ln3); }
#endif
            if (l == 0) { const int ln4 = lane_id_asm(); for (int t = gwl; t < 4096; t += NGW) knorm_task(t, KRAW, AIN(28), AIN(27), KP, ln4); }
        }
        GSYNC();
        {
            PHASE_PTRS();
            SsmW W{AIN(11) + l * 1024, AIN(12) + l * 1024, AIN(13) + l * 16, AIN(14) + (size_t)l * 16384, AIN(15) + (size_t)l * 16384, AIN(16) + (size_t)l * 16384, AIN(17) + (size_t)l * 16384, AIN(18) + l * 256};
#ifndef SKIP_SSM
            for (int r_ = 0; r_ <= REP_PC; ++r_) for (int t = gwl; t < 4096; t += NGW) ssm_task<true>(t, W, Ub, SST, YS, lds + wave * 16384, ln);
#endif
        }
        GSYNC();
        {
            PHASE_PTRS();
            pg8::Sched S; S.A0 = (const char*)AC; S.B0 = (const char*)(wl + WL_PW2); S.nM0 = M / 256; S.nN0 = 1;
            S.A1 = (const char*)YS; S.B1 = (const char*)(wl + WL_GLU); S.nM1 = M / 256; S.nN1 = 2; S.np = 2; S.K = 256; S.G = G; S.c = launder_i(blockIdx.x);
            EpiPwGlu E{ws, l};
#if !defined(SKIP_GEMM) && (!defined(GSEL) || (GSEL & 2))
            pg8::gemm_phase(lds, S, E, wave);
#endif
        }
        GSYNC();
        {
            PHASE_PTRS();
            pg8::Sched S; S.A0 = (const char*)MIX; S.B0 = (const char*)(wl + WL_OUT); S.nM0 = M / 256; S.nN0 = 4; S.A1 = nullptr; S.B1 = nullptr; S.nM1 = 0; S.nN1 = 0; S.np = 1; S.K = DM; S.G = G; S.c = launder_i(blockIdx.x);
            EpiRes E{nullptr, ws, l * 6 + SS_XA, (const LAS float*)(lds + EX_OFF)};
            { pg8::Unit u0; const int tl = wave * 64 + ln;
              if (S.next(0, u0) && tl < 256) {
                  const int row = u0.pm * 256 + tl;
                  const float r1 = __builtin_amdgcn_rsqf(SSP(l, SS_SB)[row] * (1.f / 512.f) + EPS), r2 = __builtin_amdgcn_rsqf(SSP(l, SS_CONV)[row] * (1.f / 256.f) + EPS), r3 = __builtin_amdgcn_rsqf(SSP(l, SS_SSM)[row] * (1.f / 256.f) + EPS);
                  LAS float* fac = (LAS float*)(lds + EX_OFF) + tl * 4;
                  fac[0] = r1 / r2; fac[1] = r2 / r3; fac[2] = r3; }
              __syncthreads(); }
#if !defined(SKIP_GEMM) && (!defined(GSEL) || (GSEL & 4))
            pg8::gemm_phase(lds, S, E, wave, pg8::HookMix{(const LAS float*)(lds + EX_OFF)});
#endif
        }
        GSYNC();
        {
            PHASE_PTRS();
            pg8::Sched S; S.A0 = (const char*)XB; S.B0 = (const char*)(wl + WL_Q); S.nM0 = M / 256; S.nN0 = 4; S.A1 = nullptr; S.B1 = nullptr; S.nM1 = 0; S.nN1 = 0; S.np = 1; S.K = DM; S.G = G; S.c = launder_i(blockIdx.x);
            EpiQ E{ws, l};
#if !defined(SKIP_GEMM) && (!defined(GSEL) || (GSEL & 8))
            pg8::gemm_phase(lds, S, E, wave);
#endif
        }
        if (launder_i(G) != 256) { GSYNC(); }
        else {
            asm volatile("s_waitcnt vmcnt(0)" ::: "memory"); __syncthreads();
            if (threadIdx.x == 0) { __builtin_amdgcn_fence(__ATOMIC_ACQUIRE, "agent"); asm volatile("s_waitcnt vmcnt(0)" ::: "memory"); }
            __syncthreads();
        }
        {
            PHASE_PTRS();
            pg8::SchedXA S; S.A = (const char*)MIX; S.B = (const char*)(KP + (size_t)l * 2 * 4 * 256 * 256); S.K = 256; S.G = G; S.c = launder_i(blockIdx.x);
            EpiSm E{ws, l, lds};
#if !defined(SKIP_GEMM)
            pg8::gemm_phase(lds, S, E, wave);
#endif
        }
        asm volatile("s_waitcnt vmcnt(0)" ::: "memory"); __syncthreads();
        if (threadIdx.x == 0) { __builtin_amdgcn_fence(__ATOMIC_ACQUIRE, "agent"); asm volatile("s_waitcnt vmcnt(0)" ::: "memory"); }
        __syncthreads();
        {
            PHASE_PTRS();
            pg8::SchedXA S; S.A = (const char*)HF; S.B = (const char*)(VTM + (size_t)l * 2 * 4 * 256 * 256); S.K = 256; S.G = G; S.c = launder_i(blockIdx.x);
            EpiPlain E{(unsigned char*)AOUT(), 0};
#if !defined(SKIP_GEMM)
            pg8::gemm_phase(lds, S, E, wave);
#endif
        }
        GSYNC();
        {
            PHASE_PTRS();
            pg8::Sched S; S.A0 = (const char*)XO; S.B0 = (const char*)(wl + WL_O); S.nM0 = M / 256; S.nN0 = 4; S.A1 = nullptr; S.B1 = nullptr; S.nM1 = 0; S.nN1 = 0; S.np = 1; S.K = DM; S.G = G; S.c = launder_i(blockIdx.x);
            EpiRes E{nullptr, ws, l * 6 + SS_FFN, nullptr};
#if !defined(SKIP_GEMM) && (!defined(GSEL) || (GSEL & 16))
            pg8::gemm_phase(lds, S, E, wave);
#endif
        }
        GSYNC();
        {
            PHASE_PTRS();
            pg8::Sched S; S.A0 = (const char*)XB; S.B0 = (const char*)(wl + WL_FFI); S.nM0 = M / 256; S.nN0 = 2 * FFH / 256; S.A1 = nullptr; S.B1 = nullptr; S.nM1 = 0; S.nN1 = 0; S.np = 1; S.K = DM; S.G = G; S.c = launder_i(blockIdx.x);
            EpiFfn E{ws, l};
#if !defined(SKIP_GEMM) && (!defined(GSEL) || (GSEL & 32))
            for (int r_ = 0; r_ < REP_PJ; ++r_) pg8::gemm_phase(lds, S, E, wave);
            pg8::gemm_phase(lds, S, E, wave);
#endif
            if (l == 0) {
                const int first = (G > 128) ? 128 : 0, nb = G - first;
                if ((int)blockIdx.x >= first) {
                    const int ln5 = lane_id_asm(); LAS float* scr = (LAS float*)(lds + wave * 16384);
                    for (int d = CI_DSPLIT + ((int)blockIdx.x - first) * NWAVES + wave; d < CI_DTOT; d += nb * NWAVES) convert_deferred(lds, ws, d, scr, ln5);
                }
            }
        }
        GSYNC();
        {
            PHASE_PTRS();
            pg8::Sched S; S.A0 = (const char*)HF; S.B0 = (const char*)(wl + WL_FFO); S.nM0 = M / 256; S.nN0 = 4; S.A1 = nullptr; S.B1 = nullptr; S.nM1 = 0; S.nN1 = 0; S.np = 1; S.K = FFH; S.G = G; S.c = launder_i(blockIdx.x);
            EpiRes E{(l + 1 < DEPTH) ? nullptr : AOUT(), ws, (l + 1 < DEPTH) ? (l + 1) * 6 + SS_MIX : -1, nullptr};
#if !defined(SKIP_GEMM) && (!defined(GSEL) || (GSEL & 64))
            pg8::gemm_phase(lds, S, E, wave);
#endif
        }
        if (l + 1 < DEPTH) GSYNC();
    }
}

constexpr int LDS_BYTES = 147456;

extern "C" void kernel_launch(void* const* d_in, const int* in_sizes, int n_in, void* d_out, int out_size, void* d_ws, size_t ws_size, hipStream_t stream) {
    static int grid = 0;
    if (grid == 0) {
        int dev = 0, cus = 0, per_cu = 0;
        hipGetDevice(&dev);
        hipDeviceGetAttribute(&cus, hipDeviceAttributeMultiprocessorCount, dev);
        hipFuncSetAttribute((const void*)fwd_kernel, hipFuncAttributeMaxDynamicSharedMemorySize, LDS_BYTES);
        hipOccupancyMaxActiveBlocksPerMultiprocessor(&per_cu, (const void*)fwd_kernel, NWAVES * 64, LDS_BYTES);
        (void)hipGetLastError();
        if (per_cu < 1) per_cu = 1;
        grid = cus;
        if (grid <= 0) grid = 256;
    }
    hipMemsetAsync((char*)d_ws + WS_BAR, 0, 16384, stream);
    KArgs a{};
    for (int i = 0; i < 33; ++i) a.in[i] = (const float*)d_in[i];
    a.out = (float*)d_out; a.ws = (unsigned char*)d_ws;
    void* args[] = {&a};
    hipError_t e = hipLaunchCooperativeKernel((const void*)fwd_kernel, dim3(grid), dim3(NWAVES * 64), args, LDS_BYTES, stream);
    if (e != hipSuccess) fprintf(stderr, "cooperative launch failed: %s (grid %d)\n", hipGetErrorString(e), grid);
}
```

```cpp
#include <hip/hip_runtime.h>
#include <hip/hip_cooperative_groups.h>
#include <cstdio>
#include <cstdint>
namespace cg = cooperative_groups;

#define LAS __attribute__((address_space(3)))
typedef unsigned short bf16_t;
typedef short bf16x8 __attribute__((ext_vector_type(8)));
typedef short s16x4 __attribute__((ext_vector_type(4)));
typedef float f32x4 __attribute__((ext_vector_type(4)));
typedef float f32x2 __attribute__((ext_vector_type(2)));
typedef float f32x16 __attribute__((ext_vector_type(16)));
typedef unsigned u32x4 __attribute__((ext_vector_type(4)));
typedef unsigned u32x2 __attribute__((ext_vector_type(2)));

constexpr int BATCH = 2, SEQ = 8192, DM = 1024, M = BATCH * SEQ, DEPTH = 2;
constexpr int NIN = 2304, FFH = 2816, NMEM = 256;
constexpr float EPS = 1e-6f;
constexpr float LOG2E = 1.4426950408889634f;
constexpr int NWAVES = 8;

constexpr size_t MiB = 1u << 20;
constexpr size_t WS_SS = 0;
constexpr size_t WS_BAR = 768 * 1024;
constexpr size_t WS_W = 1 * MiB;
constexpr size_t WL_IN = 0, WL_OUT = 4718592, WL_Q = 6815744, WL_O = 8912896, WL_FFI = 11010048, WL_FFO = 22544384, WL_PW2 = 28311552, WL_GLU = 28442624, WL_STRIDE = 28704768;
constexpr size_t WS_WKV = WS_W + 2 * WL_STRIDE;
constexpr size_t WS_XB = 64 * MiB;
constexpr size_t WS_RA = 96 * MiB;
constexpr size_t WS_Q = WS_RA, WS_K = WS_RA + 16 * MiB, WS_VT = WS_RA + 32 * MiB, WS_HC = WS_RA + 48 * MiB, WS_U = WS_RA + 56 * MiB,
                 WS_AC = WS_RA + 64 * MiB, WS_YS = WS_RA + 72 * MiB, WS_KRAW = WS_RA + 80 * MiB;
constexpr size_t WS_HF = WS_RA;
constexpr size_t WS_MIX = 184 * MiB;
constexpr size_t WS_XL = 216 * MiB;
constexpr size_t WS_SSQ = 255 * MiB;
constexpr size_t WS_SST = 248 * MiB, WS_KP = 250 * MiB, WS_VTM = 252 * MiB, WS_HMN = 254 * MiB;
static_assert(WS_WKV + 2 * 2048 * 1024 * 2 <= WS_XB, "weights fit");

enum { SS_MIX = 0, SS_SB = 1, SS_CONV = 2, SS_SSM = 3, SS_XA = 4, SS_FFN = 5 };

typedef __bf16 bf16x2_t __attribute__((ext_vector_type(2)));
__device__ __forceinline__ unsigned cvt_pk_bf16(float lo, float hi) { f32x2 v = {lo, hi}; bf16x2_t b = __builtin_convertvector(v, bf16x2_t); return __builtin_bit_cast(unsigned, b); }
__device__ __forceinline__ bf16_t f2bf(float f) { unsigned u = __builtin_bit_cast(unsigned, f); return (bf16_t)((u + 0x7fffu + ((u >> 16) & 1u)) >> 16); }
__device__ __forceinline__ float bf2f(unsigned short b) { return __builtin_bit_cast(float, (unsigned)b << 16); }
__device__ __forceinline__ float bflo(unsigned w) { return __builtin_bit_cast(float, w << 16); }
__device__ __forceinline__ float bfhi(unsigned w) { return __builtin_bit_cast(float, w & 0xffff0000u); }
__device__ __forceinline__ float ex2(float x) { return __builtin_amdgcn_exp2f(x); }
__device__ __forceinline__ float lg2(float x) { return __builtin_amdgcn_logf(x); }
__device__ __forceinline__ float sigmoidf_(float x) { return __builtin_amdgcn_rcpf(1.f + ex2(-x * LOG2E)); }
__device__ __forceinline__ int crow(int r, int hi) { return (r & 3) + 8 * (r >> 2) + 4 * hi; }
template <int MASK> __device__ __forceinline__ float xshfl(float v) {
    if constexpr (MASK == 32) {
        const unsigned u = __builtin_bit_cast(unsigned, v);
        auto rr = __builtin_amdgcn_permlane32_swap(u, u, false, false);
        const bool up = (__builtin_amdgcn_mbcnt_hi(~0u, __builtin_amdgcn_mbcnt_lo(~0u, 0u)) & 32u) != 0u;
        return __builtin_bit_cast(float, up ? (unsigned)rr[0] : (unsigned)rr[1]);
    } else {
        return __builtin_bit_cast(float, __builtin_amdgcn_ds_swizzle(__builtin_bit_cast(int, v), (MASK << 10) | 0x1f));
    }
}
__device__ __forceinline__ float wave_sum(float v) {
    v += xshfl<1>(v); v += xshfl<2>(v); v += xshfl<4>(v); v += xshfl<8>(v); v += xshfl<16>(v); v += xshfl<32>(v);
    return v;
}
#define MFMA32(a, b, c) __builtin_amdgcn_mfma_f32_32x32x16_bf16((a), (b), (c), 0, 0, 0)
#define MFMA16(a, b, c) __builtin_amdgcn_mfma_f32_16x16x32_bf16((a), (b), (c), 0, 0, 0)

namespace pg8 {
constexpr int BM = 256, BK = 64, HALF = 128, HTB = HALF * BK * 2, STAGE_BYTES = 8 * HTB, NXCD = 8, WGM = 8;
__device__ __forceinline__ int lds_byte(int r, int c) { const int st = (r >> 4) * 2 + (c >> 5), rr = r & 15, cc = c & 31, ob = rr * 64 + cc * 2; return st * 1024 + (ob ^ (((ob >> 9) & 1) << 5)); }
__device__ __forceinline__ void stage_rc(int b, int& R, int& C) { const int st = b / 1024, sb = b % 1024, swz = sb ^ (((sb >> 9) & 1) << 5); R = (st >> 1) * 16 + swz / 64; C = (st & 1) * 32 + (swz % 64) / 2; }
__device__ __forceinline__ int perm32(int rho) { const int n = rho >> 4, i = rho & 15; return 8 * (i >> 2) + 4 * n + (i & 3); }

struct Unit { int pm, pn, prob; const char* a; const char* b; };
struct Sched {
    const char *A0, *A1, *B0, *B1; int nM0, nM1, nN0, nN1; int np, K, G, c;
    __device__ __forceinline__ int lda() const { return K; }
    __device__ __forceinline__ int ldb() const { return K; }
    __device__ __forceinline__ bool next(int i, Unit& u) const {
        long L = (long)i * G + c; int p = 0;
        const int n0 = nM0 * nN0;
        if (L >= n0) { if (np < 2) return false; L -= n0; p = 1; if (L >= nM1 * nN1) return false; }
        const int nm = p ? nM1 : nM0, nn = p ? nN1 : nN0, nwg = nm * nn;
        int wgid = (int)L; { const int q = nwg / NXCD, r = nwg % NXCD, xcd = wgid % NXCD, off = wgid / NXCD; wgid = (xcd < r ? xcd * (q + 1) : r * (q + 1) + (xcd - r) * q) + off; }
        const int nig = WGM * nn, gid = wgid / nig, fm = gid * WGM, gsz = (nm - fm) < WGM ? (nm - fm) : WGM;
        u.pm = fm + ((wgid % nig) % gsz); u.pn = (wgid % nig) / gsz; u.prob = p;
        const size_t tstep = (size_t)BM * K * 2;
        u.a = (p ? A1 : A0) + (size_t)u.pm * tstep; u.b = (p ? B1 : B0) + (size_t)u.pn * tstep; return true;
    }
};

struct SchedXA {
    const char* A; const char* B; int K, G, c;
    __device__ __forceinline__ int lda() const { return 1024; }
    __device__ __forceinline__ int ldb() const { return 256; }
    __device__ __forceinline__ bool next(int i, Unit& u) const {
        const long L = (long)i * G + c; if (L >= 256) return false;
        const int v = (int)L, xq = v & 7, off = v >> 3, pm = 8 * xq + (off & 7), head = off >> 3, b = pm >> 5, bh = b * 4 + head;
        u.pm = pm; u.pn = head; u.prob = 0;
        u.a = A + ((size_t)u.pm * 256 * 1024 + (size_t)head * 256) * 2; u.b = B + (size_t)bh * 256 * 256 * 2; return true;
    }
};
__device__ __forceinline__ int lane_id_asm_() { int l; asm volatile("v_mbcnt_lo_u32_b32 %0, -1, 0\n\tv_mbcnt_hi_u32_b32 %0, -1, %0" : "=v"(l)); return l; }
struct NoHook { __device__ __forceinline__ void operator()(int, f32x4 (&)[2][2][4][2], int, int) const {} };
struct HookMix {
    const LAS float* fac;
    __device__ __forceinline__ void operator()(int t, f32x4 (&acc)[2][2][4][2], int wr, int fr) const {
        if (t == 8 || t == 12) {
            const int idx = (t == 8) ? 0 : 1;
#pragma unroll
            for (int ai = 0; ai < 2; ++ai)
#pragma unroll
                for (int m = 0; m < 4; ++m) {
                    const float f = fac[(ai * 128 + wr * 64 + m * 16 + fr) * 4 + idx];
#pragma unroll
                    for (int bj = 0; bj < 2; ++bj)
#pragma unroll
                        for (int n = 0; n < 2; ++n) acc[ai][bj][m][n] *= f;
                }
        }
    }
};
template <class Epi, class SchedT, class HookT = NoHook>
__device__ __forceinline__ void gemm_phase(LAS unsigned char* lds, const SchedT& S, const Epi& E, int wave_, const HookT& H = HookT()) {
    const int tid_ = wave_ * 64 + lane_id_asm_();
    int K_ = S.K; asm volatile("" : "+s"(K_));
    const int tid = tid_, wid = __builtin_amdgcn_readfirstlane(tid >> 6), lane = tid & 63, wr = wid >> 2, wc = wid & 3, fr = lane & 15, fq = lane >> 4;
    const int K = K_, nt = K / BK;
    unsigned voffA[2], voffB[2];
#pragma unroll
    for (int i = 0; i < 2; ++i) { int R, C; stage_rc(tid * 16 + i * 8192, R, C); const int Rb = (R & ~31) + perm32(R & 31);
        voffA[i] = (unsigned)(R * S.lda() + C) * 2u; voffB[i] = (unsigned)(Rb * S.ldb() + C) * 2u; }
    const size_t kstep = (size_t)(BK * 2);
    const size_t hstepA = (size_t)HALF * S.lda() * 2, hstepB = (size_t)HALF * S.ldb() * 2;
    const unsigned ldsw = (unsigned)wid * 1024u;
    const int aoff = lds_byte(wr * 64 + fr, fq * 8), boff = lds_byte(wc * 32 + fr, fq * 8);
#define PG8_SA(b, h) (((b) * 2 + (h)) * HTB)
#define PG8_SB(b, h) ((4 + (b) * 2 + (h)) * HTB)
#define PG8_STAGE(bufoff, gbase, voff) do { _Pragma("unroll") for (int _i = 0; _i < 2; ++_i) \
        __builtin_amdgcn_global_load_lds((const unsigned*)((const char*)(gbase) + (voff)[_i]), (LAS unsigned*)(lds + (bufoff) + ldsw + _i * 8192), 16, 0, 0); } while (0)
#define PG8_LDA(dst, b, h) do { _Pragma("unroll") for (int m = 0; m < 4; ++m) _Pragma("unroll") for (int k = 0; k < 2; ++k) dst[m][k] = *(const LAS bf16x8*)(lds + PG8_SA(b, h) + aoff + m * 2048 + k * 1024); } while (0)
#define PG8_LDB(dst, b, h) do { _Pragma("unroll") for (int n = 0; n < 2; ++n) _Pragma("unroll") for (int k = 0; k < 2; ++k) dst[n][k] = *(const LAS bf16x8*)(lds + PG8_SB(b, h) + boff + n * 2048 + k * 1024); } while (0)
#define PG8_MMA(ai, bj, At, Bt) do { __builtin_amdgcn_s_setprio(1); _Pragma("unroll") for (int m = 0; m < 4; ++m) _Pragma("unroll") for (int n = 0; n < 2; ++n) _Pragma("unroll") for (int k = 0; k < 2; ++k) \
        acc[ai][bj][m][n] = __builtin_amdgcn_mfma_f32_16x16x32_bf16(Bt[n][k], At[m][k], acc[ai][bj][m][n], 0, 0, 0); __builtin_amdgcn_s_setprio(0); } while (0)
#define PG8_WAIT_V(n) asm volatile("s_waitcnt vmcnt(" #n ")" ::: "memory")
#define PG8_WAIT_L(n) asm volatile("s_waitcnt lgkmcnt(" #n ")" ::: "memory")
#define PG8_BAR __builtin_amdgcn_s_barrier()
#define PG8_SCHED __builtin_amdgcn_sched_barrier(0)
    Unit cur, nxt; int ui = 0;
    if (!S.next(0, cur)) return;
    f32x4 acc[2][2][4][2];
#pragma unroll
    for (int a = 0; a < 2; ++a)
#pragma unroll
        for (int b = 0; b < 2; ++b)
#pragma unroll
            for (int m = 0; m < 4; ++m)
#pragma unroll
                for (int n = 0; n < 2; ++n) acc[a][b][m][n] = (f32x4){0.f, 0.f, 0.f, 0.f};
    bf16x8 At[4][2], B0[2][2], B1[2][2];
    const char* cA = cur.a; const char* cB = cur.b;
    PG8_STAGE(PG8_SB(0, 0), cB, voffB); PG8_STAGE(PG8_SB(0, 1), cB + hstepB, voffB); PG8_STAGE(PG8_SA(0, 0), cA, voffA); PG8_STAGE(PG8_SA(0, 1), cA + hstepA, voffA);
    if (wr == 1) PG8_BAR;
    PG8_WAIT_V(2); PG8_BAR;
    PG8_STAGE(PG8_SB(1, 0), cB + kstep, voffB); PG8_STAGE(PG8_SA(1, 0), cA + kstep, voffA); PG8_STAGE(PG8_SB(1, 1), cB + hstepB + kstep, voffB);
    PG8_WAIT_V(6); PG8_BAR;
    for (;;) {
        const bool has_next = S.next(ui + 1, nxt);
        const char* nA = has_next ? nxt.a : cA; const char* nB = has_next ? nxt.b : cB;
        for (int t = 0; t < nt; t += 2) {
            H(t, acc, wr, fr);
            const bool last = (t == nt - 2);
            const char* a1 = cA + (size_t)(t + 1) * kstep;
            const char* a2 = last ? nA : cA + (size_t)(t + 2) * kstep; const char* b2 = last ? nB : cB + (size_t)(t + 2) * kstep;
            const char* a3 = a2 + kstep; const char* b3 = b2 + kstep;
            PG8_LDB(B0, 0, 0); PG8_LDB(B1, 0, 1); PG8_SCHED; PG8_LDA(At, 0, 0); PG8_STAGE(PG8_SA(1, 1), a1 + hstepA, voffA);
            PG8_WAIT_V(8); PG8_WAIT_L(0); PG8_BAR; PG8_MMA(0, 0, At, B0); PG8_MMA(0, 1, At, B1); PG8_BAR; PG8_SCHED;
            PG8_LDA(At, 0, 1); PG8_STAGE(PG8_SB(0, 0), b2, voffB); PG8_STAGE(PG8_SB(0, 1), b2 + hstepB, voffB); PG8_STAGE(PG8_SA(0, 0), a2, voffA);
            PG8_WAIT_V(8); PG8_WAIT_L(0); PG8_BAR; PG8_MMA(1, 0, At, B0); PG8_MMA(1, 1, At, B1); PG8_BAR; PG8_SCHED;
            PG8_LDB(B0, 1, 0); PG8_LDB(B1, 1, 1); PG8_SCHED; PG8_LDA(At, 1, 0); PG8_STAGE(PG8_SA(0, 1), a2 + hstepA, voffA);
            PG8_WAIT_V(8); PG8_WAIT_L(0); PG8_BAR; PG8_MMA(0, 0, At, B0); PG8_MMA(0, 1, At, B1); PG8_BAR; PG8_SCHED;
            PG8_LDA(At, 1, 1); PG8_STAGE(PG8_SB(1, 0), b3, voffB); PG8_STAGE(PG8_SB(1, 1), b3 + hstepB, voffB); PG8_STAGE(PG8_SA(1, 0), a3, voffA);
            PG8_WAIT_V(8); PG8_WAIT_L(0); PG8_BAR; PG8_MMA(1, 0, At, B0); PG8_MMA(1, 1, At, B1); PG8_BAR; PG8_SCHED;
        }
        if (wr == 0) PG8_BAR;
        E(acc, cur, wr, wc, fr, fq);
        if (!has_next) break;
#pragma unroll
        for (int a = 0; a < 2; ++a)
#pragma unroll
            for (int b = 0; b < 2; ++b)
#pragma unroll
                for (int m = 0; m < 4; ++m)
#pragma unroll
                    for (int n = 0; n < 2; ++n) acc[a][b][m][n] = (f32x4){0.f, 0.f, 0.f, 0.f};
        cur = nxt; cA = nA; cB = nB; ++ui;
        if (wr == 1) PG8_BAR;
    }
    PG8_WAIT_V(0);
    PG8_BAR;
#undef PG8_SA
#undef PG8_SB
#undef PG8_STAGE
#undef PG8_LDA
#undef PG8_LDB
#undef PG8_MMA
#undef PG8_WAIT_V
#undef PG8_WAIT_L
#undef PG8_BAR
#undef PG8_SCHED
}
}
using pg8::Unit;
#define GASP __attribute__((address_space(1)))
__device__ __forceinline__ unsigned char* launder(unsigned char* p) { unsigned long long v = (unsigned long long)p; asm volatile("" : "+s"(v)); return (unsigned char*)(GASP unsigned char*)v; }
__device__ __forceinline__ int lane_id_asm() { int l; asm volatile("v_mbcnt_lo_u32_b32 %0, -1, 0\n\tv_mbcnt_hi_u32_b32 %0, -1, %0" : "=v"(l)); return l; }
__device__ __forceinline__ int launder_i(int v) { asm volatile("" : "+s"(v)); return v; }
#define SSP(l, k) ((float*)(ws + WS_SS) + (size_t)((l) * 6 + (k)) * M)
typedef f32x4 Acc[2][2][4][2];

__device__ __forceinline__ void st16(bf16_t* p, const float* v) {
    u32x4 w; w.x = cvt_pk_bf16(v[0], v[1]); w.y = cvt_pk_bf16(v[2], v[3]); w.z = cvt_pk_bf16(v[4], v[5]); w.w = cvt_pk_bf16(v[6], v[7]);
    *(u32x4*)p = w;
}

__device__ __forceinline__ void load_rs(float (&rs)[2][4], const float* ssx, int row0) {
#pragma unroll
    for (int ai = 0; ai < 2; ++ai)
#pragma unroll
        for (int m = 0; m < 4; ++m) rs[ai][m] = ssx[row0 + ai * 128 + m * 16];
#pragma unroll
    for (int ai = 0; ai < 2; ++ai)
#pragma unroll
        for (int m = 0; m < 4; ++m) rs[ai][m] = __builtin_amdgcn_rsqf(rs[ai][m] * (1.f / 1024.f) + EPS);
}
__device__ __forceinline__ void st16_nt(bf16_t* p, const float* v) {
    u32x4 w; w.x = cvt_pk_bf16(v[0], v[1]); w.y = cvt_pk_bf16(v[2], v[3]); w.z = cvt_pk_bf16(v[4], v[5]); w.w = cvt_pk_bf16(v[6], v[7]);
    __builtin_nontemporal_store(w, (u32x4*)p);
}
struct EpiIn {
    unsigned char* ws_; int l; const float* qg; const float* kg;
    __device__ __forceinline__ void operator()(const Acc& acc, const Unit& u, int wr, int wc, int fr, int fq) const {
        unsigned char* ws = launder(ws_);
        const float* ssx = SSP(l, SS_MIX);
        bf16_t* Q = (bf16_t*)(ws + WS_Q); bf16_t* Kb = (bf16_t*)(ws + WS_K); bf16_t* Vt = (bf16_t*)(ws + WS_VT); bf16_t* HC = (bf16_t*)(ws + WS_HC); bf16_t* U = (bf16_t*)(ws + WS_U);
        float* kraw = (float*)(ws + WS_KRAW); bf16_t* vtm = (bf16_t*)(ws + WS_VTM);
        if (u.prob == 0) {
            const int pn = u.pn;
            float rsv[2][4]; load_rs(rsv, ssx, u.pm * 256 + wr * 64 + fr);
            if (pn < 4) {
                const float* g = (pn < 2) ? qg : kg; bf16_t* dst = (pn < 2) ? Q : Kb;
                const float post = (pn < 2) ? 0.125f * LOG2E : 1.0f;
                const int head = 4 * (pn & 1) + wc;
#pragma unroll
                for (int ai = 0; ai < 2; ++ai)
#pragma unroll
                    for (int m = 0; m < 4; ++m) {
                        const int row = u.pm * 256 + ai * 128 + wr * 64 + m * 16 + fr;
                        const float rs = rsv[ai][m];
                        f32x4 v[2][2]; float ss = 0.f;
#pragma unroll
                        for (int bj = 0; bj < 2; ++bj)
#pragma unroll
                            for (int n = 0; n < 2; ++n) { v[bj][n] = acc[ai][bj][m][n] * rs; const f32x4 x = v[bj][n]; ss += (x[0] * x[0] + x[1] * x[1]) + (x[2] * x[2] + x[3] * x[3]); }
                        ss += xshfl<16>(ss); ss += xshfl<32>(ss);
                        const float hn = __builtin_amdgcn_rsqf(ss * (1.f / 64.f) + EPS) * post;
#pragma unroll
                        for (int bj = 0; bj < 2; ++bj) {
                            float o[8];
#pragma unroll
                            for (int n = 0; n < 2; ++n) { const f32x4 gv = *(const f32x4*)(g + 32 * bj + 8 * fq + 4 * n);
#pragma unroll
                                for (int j = 0; j < 4; ++j) o[4 * n + j] = v[bj][n][j] * hn * gv[j]; }
                            st16(dst + (size_t)row * 512 + head * 64 + 32 * bj + 8 * fq, o);
                        }
                        asm volatile("" ::: "memory");
                    }
            } else if (pn < 6) {
#pragma unroll
                for (int ai = 0; ai < 2; ++ai)
#pragma unroll
                    for (int m = 0; m < 4; ++m) {
                        const int row = u.pm * 256 + ai * 128 + wr * 64 + m * 16 + fr;
                        const float rs = rsv[ai][m];
                        const int b = row >> 13, t = row & (SEQ - 1);
#pragma unroll
                        for (int bj = 0; bj < 2; ++bj) {
                            const int h = 4 * (pn - 4) + 2 * bj + (wc >> 1);
                            const bool odd = (fr & 1) != 0;
#pragma unroll
                            for (int n = 0; n < 2; ++n)
#pragma unroll
                                for (int jp = 0; jp < 2; ++jp) {
                                    const float v0 = acc[ai][bj][m][n][2 * jp] * rs, v1 = acc[ai][bj][m][n][2 * jp + 1] * rs;
                                    const float send = odd ? v0 : v1;
                                    const float recv = __builtin_bit_cast(float, __builtin_amdgcn_update_dpp(0, __builtin_bit_cast(int, send), 0xB1, 0xF, 0xF, true));
                                    const int d = 32 * (wc & 1) + 8 * fq + 4 * n + 2 * jp + (odd ? 1 : 0);
                                    const unsigned w = odd ? cvt_pk_bf16(recv, v1) : cvt_pk_bf16(v0, recv);
                                    *(unsigned*)(Vt + ((size_t)(b * 8 + h) * 64 + d) * SEQ + (t & ~1)) = w;
                                }
                        }
                    }
            } else if (pn < 8) {
#pragma unroll
                for (int ai = 0; ai < 2; ++ai)
#pragma unroll
                    for (int m = 0; m < 4; ++m) {
                        const int row = u.pm * 256 + ai * 128 + wr * 64 + m * 16 + fr;
                        const float rs = rsv[ai][m];
                        float o[8];
#pragma unroll
                        for (int n = 0; n < 2; ++n)
#pragma unroll
                            for (int j = 0; j < 4; ++j) { const float a = acc[ai][0][m][n][j] * rs, b = acc[ai][1][m][n][j] * rs; o[4 * n + j] = a * sigmoidf_(b); }
                        st16(HC + (size_t)row * 256 + 128 * (pn - 6) + 32 * wc + 8 * fq, o);
                    }
            } else {
#pragma unroll
                for (int ai = 0; ai < 2; ++ai)
#pragma unroll
                    for (int m = 0; m < 4; ++m) {
                        const int row = u.pm * 256 + ai * 128 + wr * 64 + m * 16 + fr;
                        const float rs = rsv[ai][m];
#pragma unroll
                        for (int bj = 0; bj < 2; ++bj) {
                            float o[8];
#pragma unroll
                            for (int n = 0; n < 2; ++n)
#pragma unroll
                                for (int j = 0; j < 4; ++j) o[4 * n + j] = acc[ai][bj][m][n][j] * rs;
                            st16(U + (size_t)row * 256 + 128 * bj + 32 * wc + 8 * fq, o);
                        }
                    }
            }
        } else {
            const int lay = u.pn >> 3, sub = u.pn & 7;
#pragma unroll
            for (int ai = 0; ai < 2; ++ai)
#pragma unroll
                for (int m = 0; m < 4; ++m) {
                    const int row = u.pm * 256 + ai * 128 + wr * 64 + m * 16 + fr;
                    if (sub < 4) {
#pragma unroll
                        for (int bj = 0; bj < 2; ++bj)
#pragma unroll
                            for (int n = 0; n < 2; ++n)
                                *(f32x4*)(kraw + ((size_t)lay * 512 + row) * 1024 + sub * 256 + 128 * bj + 32 * wc + 8 * fq + 4 * n) = acc[ai][bj][m][n];
                    } else {
                        const int b = row >> 8, mt = row & 255, head = sub - 4;
#pragma unroll
                        for (int bj = 0; bj < 2; ++bj)
#pragma unroll
                            for (int n = 0; n < 2; ++n)
#pragma unroll
                                for (int j = 0; j < 4; ++j) {
                                    const int d = 128 * bj + 32 * wc + 8 * fq + 4 * n + j;
                                    vtm[((size_t)((lay * 2 + b) * 4 + head) * 256 + d) * 256 + mt] = f2bf(acc[ai][bj][m][n][j]);
                                }
                    }
                }
        }
    }
};

struct EpiPwGlu {
    unsigned char* ws_; int l;
    __device__ __forceinline__ void operator()(const Acc& acc, const Unit& u, int wr, int wc, int fr, int fq) const {
        unsigned char* ws = launder(ws_);
        bf16_t* MIX = (bf16_t*)(ws + WS_MIX); float* ss_conv = SSP(l, SS_CONV);
#pragma unroll
        for (int ai = 0; ai < 2; ++ai)
#pragma unroll
            for (int m = 0; m < 4; ++m) {
                const int row = u.pm * 256 + ai * 128 + wr * 64 + m * 16 + fr;
                float ss = 0.f;
                if (u.prob == 0) {
#pragma unroll
                    for (int bj = 0; bj < 2; ++bj) {
                        float o[8];
#pragma unroll
                        for (int n = 0; n < 2; ++n)
#pragma unroll
                            for (int j = 0; j < 4; ++j) { o[4 * n + j] = acc[ai][bj][m][n][j]; ss += o[4 * n + j] * o[4 * n + j]; }
                        st16(MIX + (size_t)row * 1024 + 512 + 128 * bj + 32 * wc + 8 * fq, o);
                    }
                } else {
                    float o[8];
#pragma unroll
                    for (int n = 0; n < 2; ++n)
#pragma unroll
                        for (int j = 0; j < 4; ++j) { const float v = acc[ai][0][m][n][j] * sigmoidf_(acc[ai][1][m][n][j]); o[4 * n + j] = v; ss += v * v; }
                    st16(MIX + (size_t)row * 1024 + 768 + 128 * u.pn + 32 * wc + 8 * fq, o);
                }
                ss += xshfl<16>(ss); ss += xshfl<32>(ss);
                if (fq == 0) atomicAdd(ss_conv + (size_t)u.prob * M + row, ss);
            }
    }
};

struct EpiRes {
    float* xfinal; unsigned char* ws_; int ssidx;
    const LAS float* fac;
    __device__ __forceinline__ void operator()(const Acc& acc, const Unit& u, int wr, int wc, int fr, int fq) const {
        unsigned char* ws = launder(ws_);
        bf16_t* XB = (bf16_t*)(ws + WS_XB); float* ssn = ssidx >= 0 ? (float*)(ws + WS_SS) + (size_t)ssidx * M : nullptr;
#pragma unroll
        for (int ai = 0; ai < 2; ++ai) {
            u32x4 xh[4][2];
#pragma unroll
            for (int m = 0; m < 4; ++m) {
                const size_t off = (size_t)(u.pm * 256 + ai * 128 + wr * 64 + m * 16 + fr) * 1024 + u.pn * 256 + 32 * wc + 8 * fq;
#pragma unroll
                for (int bj = 0; bj < 2; ++bj) xh[m][bj] = *(const u32x4*)(XB + off + 128 * bj);
            }
#pragma unroll
            for (int m = 0; m < 4; ++m) {
                const int row = u.pm * 256 + ai * 128 + wr * 64 + m * 16 + fr;
                const float f3 = fac ? fac[(ai * 128 + wr * 64 + m * 16 + fr) * 4 + 2] : 1.f;
                float ss = 0.f;
#pragma unroll
                for (int bj = 0; bj < 2; ++bj) {
                    const size_t off = (size_t)row * 1024 + u.pn * 256 + 128 * bj + 32 * wc + 8 * fq;
                    float o[8];
#pragma unroll
                    for (int n = 0; n < 2; ++n)
#pragma unroll
                        for (int j = 0; j < 4; ++j) {
                            const int e = 4 * n + j; const unsigned wh = xh[m][bj][e >> 1];
                            const float v = ((e & 1) ? bfhi(wh) : bflo(wh)) + acc[ai][bj][m][n][j] * f3;
                            o[e] = v; ss += v * v;
                        }
                    if (xfinal) { *(f32x4*)(xfinal + off) = (f32x4){o[0], o[1], o[2], o[3]}; *(f32x4*)(xfinal + off + 4) = (f32x4){o[4], o[5], o[6], o[7]}; }
                    else st16(XB + off, o);
                }
                if (ssn) { ss += xshfl<16>(ss); ss += xshfl<32>(ss); if (fq == 0) atomicAdd(ssn + row, ss); }
            }
            asm volatile("" ::: "memory");
        }
    }
};

struct EpiQ {
    unsigned char* ws_; int l;
    __device__ __forceinline__ void operator()(const Acc& acc, const Unit& u, int wr, int wc, int fr, int fq) const {
        unsigned char* ws = launder(ws_);
        const float* ssx = SSP(l, SS_XA); bf16_t* XQ = (bf16_t*)(ws + WS_MIX);
        float rsv[2][4]; load_rs(rsv, ssx, u.pm * 256 + wr * 64 + fr);
#pragma unroll
        for (int ai = 0; ai < 2; ++ai)
#pragma unroll
            for (int m = 0; m < 4; ++m) {
                const int row = u.pm * 256 + ai * 128 + wr * 64 + m * 16 + fr;
                const float rs = rsv[ai][m];
                float ss = 0.f;
#pragma unroll
                for (int bj = 0; bj < 2; ++bj) {
                    float o[8];
#pragma unroll
                    for (int n = 0; n < 2; ++n)
#pragma unroll
                        for (int j = 0; j < 4; ++j) { o[4 * n + j] = acc[ai][bj][m][n][j] * rs; ss += o[4 * n + j] * o[4 * n + j]; }
                    st16(XQ + (size_t)row * 1024 + u.pn * 256 + 128 * bj + 32 * wc + 8 * fq, o);
                }
                ss += xshfl<16>(ss); ss += xshfl<32>(ss);
                if (fq == 0) atomicAdd((float*)(ws + WS_SSQ) + (size_t)(l * 4 + u.pn) * M + row, ss);
                asm volatile("" ::: "memory");
            }
    }
};

struct EpiFfn {
    unsigned char* ws_; int l;
    __device__ __forceinline__ void operator()(const Acc& acc, const Unit& u, int wr, int wc, int fr, int fq) const {
        unsigned char* ws = launder(ws_);
        const float* ssx = SSP(l, SS_FFN); bf16_t* HF = (bf16_t*)(ws + WS_HF);
        float rsv[2][4]; load_rs(rsv, ssx, u.pm * 256 + wr * 64 + fr);
#pragma unroll
        for (int ai = 0; ai < 2; ++ai)
#pragma unroll
            for (int m = 0; m < 4; ++m) {
                const int row = u.pm * 256 + ai * 128 + wr * 64 + m * 16 + fr;
                const float rs = rsv[ai][m];
                float o[8];
#pragma unroll
                for (int n = 0; n < 2; ++n)
#pragma unroll
                    for (int j = 0; j < 4; ++j) { const float g = acc[ai][0][m][n][j] * rs, up = acc[ai][1][m][n][j] * rs; o[4 * n + j] = g * sigmoidf_(g) * up; }
                st16_nt(HF + (size_t)row * FFH + 128 * u.pn + 32 * wc + 8 * fq, o);
            }
    }
};

constexpr int EX_OFF = 131072 + 4096;
struct EpiSm {
    unsigned char* ws_; int l; LAS unsigned char* lds;
    __device__ __forceinline__ void operator()(const Acc& acc, const Unit& u, int wr, int wc, int fr, int fq) const {
        unsigned char* ws = launder(ws_);
        const float* ssq = (const float*)(ws + WS_SSQ) + (size_t)(l * 4 + u.pn) * M;
        bf16_t* P = (bf16_t*)(ws + WS_HF);
        LAS float* EXm = (LAS float*)(lds + EX_OFF); LAS float* EXs = EXm + 1024;
        float rq[2][4], mx[2][4];
#pragma unroll
        for (int ai = 0; ai < 2; ++ai)
#pragma unroll
            for (int m = 0; m < 4; ++m) {
                const int rl = ai * 128 + wr * 64 + m * 16 + fr;
                rq[ai][m] = __builtin_amdgcn_rsqf(ssq[u.pm * 256 + rl] * (1.f / 256.f) + EPS) * (0.0625f * LOG2E);
                float v = -3.0e38f;
#pragma unroll
                for (int bj = 0; bj < 2; ++bj)
#pragma unroll
                    for (int n = 0; n < 2; ++n)
#pragma unroll
                        for (int j = 0; j < 4; ++j) v = fmaxf(v, acc[ai][bj][m][n][j]);
                v *= rq[ai][m];
                v = fmaxf(v, xshfl<16>(v)); v = fmaxf(v, xshfl<32>(v));
                if (fq == 0) EXm[rl * 4 + wc] = v;
            }
        asm volatile("s_waitcnt lgkmcnt(0)" ::: "memory"); __builtin_amdgcn_s_barrier(); asm volatile("" ::: "memory");
#pragma unroll
        for (int ai = 0; ai < 2; ++ai)
#pragma unroll
            for (int m = 0; m < 4; ++m) {
                const int rl = ai * 128 + wr * 64 + m * 16 + fr;
                const f32x4 e = *(const LAS f32x4*)(EXm + rl * 4);
                mx[ai][m] = fmaxf(fmaxf(e[0], e[1]), fmaxf(e[2], e[3]));
                float s = 0.f;
#pragma unroll
                for (int bj = 0; bj < 2; ++bj)
#pragma unroll
                    for (int n = 0; n < 2; ++n)
#pragma unroll
                        for (int j = 0; j < 4; ++j) s += ex2(acc[ai][bj][m][n][j] * rq[ai][m] - mx[ai][m]);
                s += xshfl<16>(s); s += xshfl<32>(s);
                if (fq == 0) EXs[rl * 4 + wc] = s;
            }
        asm volatile("s_waitcnt lgkmcnt(0)" ::: "memory"); __builtin_amdgcn_s_barrier(); asm volatile("" ::: "memory");
#pragma unroll
        for (int ai = 0; ai < 2; ++ai)
#pragma unroll
            for (int m = 0; m < 4; ++m) {
                const int rl = ai * 128 + wr * 64 + m * 16 + fr;
                const f32x4 e = *(const LAS f32x4*)(EXs + rl * 4);
                const float inv = __builtin_amdgcn_rcpf((e[0] + e[1]) + (e[2] + e[3]));
#pragma unroll
                for (int bj = 0; bj < 2; ++bj) {
                    float o[8];
#pragma unroll
                    for (int n = 0; n < 2; ++n)
#pragma unroll
                        for (int j = 0; j < 4; ++j) o[4 * n + j] = ex2(acc[ai][bj][m][n][j] * rq[ai][m] - mx[ai][m]) * inv;
                    st16(P + (size_t)(u.pm * 256 + rl) * 1024 + u.pn * 256 + 128 * bj + 32 * wc + 8 * fq, o);
                }
            }
    }
};
struct EpiPlain {
    unsigned char* ws_; size_t off;
    __device__ __forceinline__ void operator()(const Acc& acc, const Unit& u, int wr, int wc, int fr, int fq) const {
        bf16_t* O = (bf16_t*)(launder(ws_) + off);
#pragma unroll
        for (int ai = 0; ai < 2; ++ai)
#pragma unroll
            for (int m = 0; m < 4; ++m) {
                const int row = u.pm * 256 + ai * 128 + wr * 64 + m * 16 + fr;
#pragma unroll
                for (int bj = 0; bj < 2; ++bj) {
                    float o[8];
#pragma unroll
                    for (int n = 0; n < 2; ++n)
#pragma unroll
                        for (int j = 0; j < 4; ++j) o[4 * n + j] = acc[ai][bj][m][n][j];
                    st16(O + (size_t)row * 1024 + u.pn * 256 + 128 * bj + 32 * wc + 8 * fq, o);
                }
            }
    }
};

constexpr int XBST_OFF = 131072 + 512;
constexpr int ARGS_OFF = 131072 + 1024;
__device__ __forceinline__ unsigned char* argp(LAS unsigned char* lds, int i) {
    unsigned addr = (unsigned)(uintptr_t)(lds + ARGS_OFF) + 8u * (unsigned)i; asm volatile("" : "+s"(addr));
    const unsigned long long v = *(volatile LAS unsigned long long*)(uintptr_t)addr;
    const unsigned lo = __builtin_amdgcn_readfirstlane((unsigned)v), hi = __builtin_amdgcn_readfirstlane((unsigned)(v >> 32));
    return (unsigned char*)(GASP unsigned char*)(((unsigned long long)hi << 32) | lo);
}
#define AIN(k) ((const float*)argp(lds, (k)))
#define AOUT() ((float*)argp(lds, 33))

__device__ __forceinline__ void transpose_item(const float* W, int K, int Nsrc, bf16_t* WT, int dst_row0, int src_col0, int k0, const float* gain, LAS float* scr, int lane) {
    float wv[32];
#pragma unroll
    for (int i = 0; i < 32; ++i) wv[i] = W[(size_t)(k0 + 2 * i + (lane >> 5)) * Nsrc + src_col0 + (lane & 31)];
    if (gain) {
#pragma unroll
        for (int i = 0; i < 32; ++i) wv[i] *= gain[k0 + 2 * i + (lane >> 5)];
    }
#pragma unroll
    for (int i = 0; i < 32; ++i) scr[(2 * i + (lane >> 5)) * 33 + (lane & 31)] = wv[i];
    asm volatile("s_waitcnt lgkmcnt(0)" ::: "memory");
    const int c = lane & 7;
#pragma unroll
    for (int j = 0; j < 4; ++j) { const int n = (lane >> 3) + 8 * j; const LAS float* s = scr + (8 * c) * 33 + n;
        u32x4 o; o.x = cvt_pk_bf16(s[0 * 33], s[1 * 33]); o.y = cvt_pk_bf16(s[2 * 33], s[3 * 33]); o.z = cvt_pk_bf16(s[4 * 33], s[5 * 33]); o.w = cvt_pk_bf16(s[6 * 33], s[7 * 33]);
        *(u32x4*)(WT + (size_t)(dst_row0 + n) * K + k0 + 8 * c) = o; }
    asm volatile("s_waitcnt lgkmcnt(0)" ::: "memory");
}
__device__ __forceinline__ int colmap_in(int c) { const int pn = c >> 8, bj = (c >> 7) & 1, wc = (c >> 5) & 3;
    if (pn < 4) return 256 * pn + 64 * wc + 32 * bj;
    if (pn == 6 || pn == 7) return 1536 + 256 * bj + 128 * (pn - 6) + 32 * wc;
    return c; }
__device__ __forceinline__ int colmap_ffn(int c) { const int pn = c >> 8, bj = (c >> 7) & 1, wc = (c >> 5) & 3; return FFH * bj + 128 * pn + 32 * wc; }
__device__ __forceinline__ int colmap_glu(int c) { const int pn = c >> 8, bj = (c >> 7) & 1, wc = (c >> 5) & 3; return 256 * bj + 128 * pn + 32 * wc; }

struct KArgs { const float* in[33]; float* out; unsigned char* ws; };

__device__ __forceinline__ void transpose_job(int it, const float* W, int K, int Nsrc, int Ndst, bf16_t* WT, int dst_row_off, const float* gain, int mode, LAS float* scr, int lane) {
    const int nblk = Ndst / 32, kb = it / nblk, nb = it % nblk, n0 = 32 * nb;
    const int src = mode == 1 ? colmap_in(n0) : mode == 2 ? colmap_ffn(n0) : mode == 3 ? colmap_glu(n0) : n0;
    transpose_item(W, K, Nsrc, WT, dst_row_off + n0, src, 64 * kb, gain, scr, lane);
}

constexpr int CI_IN = (DM / 64) * (NIN / 32), CI_SQ = (DM / 64) * (DM / 32), CI_FFI = (DM / 64) * (2 * FFH / 32), CI_FFO = (FFH / 64) * (DM / 32), CI_PW2 = (256 / 64) * (256 / 32), CI_GLU = (256 / 64) * (512 / 32);
constexpr int CI_KV0 = CI_IN + 3 * CI_SQ, CI_KV1 = CI_IN + 5 * CI_SQ;
constexpr int CI_NIT = CI_IN + 5 * CI_SQ + CI_FFI + CI_FFO + CI_PW2 + CI_GLU, CI_DEFER = CI_NIT - 2 * CI_SQ;
__device__ __forceinline__ void convert_item(LAS unsigned char* lds, unsigned char* ws, int l, int it, LAS float* scr, int lane) {
    unsigned char* wl = ws + WS_W + (size_t)l * WL_STRIDE;
    int r = it;
    if (r < CI_IN) { transpose_job(r, AIN(3) + (size_t)l * DM * NIN, DM, NIN, NIN, (bf16_t*)(wl + WL_IN), 0, AIN(2) + l * DM, 1, scr, lane); return; } r -= CI_IN;
    if (r < CI_SQ) { transpose_job(r, AIN(21) + (size_t)l * DM * DM, DM, DM, DM, (bf16_t*)(wl + WL_OUT), 0, AIN(20) + l * DM, 0, scr, lane); return; } r -= CI_SQ;
    if (r < CI_SQ) { transpose_job(r, AIN(24) + (size_t)l * DM * DM, DM, DM, DM, (bf16_t*)(wl + WL_Q), 0, AIN(22) + l * DM, 0, scr, lane); return; } r -= CI_SQ;
    if (r < CI_SQ) { transpose_job(r, AIN(29) + (size_t)l * DM * DM, DM, DM, DM, (bf16_t*)(wl + WL_O), 0, nullptr, 0, scr, lane); return; } r -= CI_SQ;
    if (r < CI_SQ) { transpose_job(r, AIN(25) + (size_t)l * DM * DM, DM, DM, DM, (bf16_t*)(ws + WS_WKV) + (size_t)l * 2048 * 1024, 0, AIN(23) + l * DM, 0, scr, lane); return; } r -= CI_SQ;
    if (r < CI_SQ) { transpose_job(r, AIN(26) + (size_t)l * DM * DM, DM, DM, DM, (bf16_t*)(ws + WS_WKV) + (size_t)l * 2048 * 1024, 1024, AIN(23) + l * DM, 0, scr, lane); return; } r -= CI_SQ;
    if (r < CI_FFI) { transpose_job(r, AIN(31) + (size_t)l * DM * 2 * FFH, DM, 2 * FFH, 2 * FFH, (bf16_t*)(wl + WL_FFI), 0, AIN(30) + l * DM, 2, scr, lane); return; } r -= CI_FFI;
    if (r < CI_FFO) { transpose_job(r, AIN(32) + (size_t)l * FFH * DM, FFH, DM, DM, (bf16_t*)(wl + WL_FFO), 0, nullptr, 0, scr, lane); return; } r -= CI_FFO;
    if (r < CI_PW2) { transpose_job(r, AIN(10) + (size_t)l * 256 * 256, 256, 256, 256, (bf16_t*)(wl + WL_PW2), 0, nullptr, 0, scr, lane); return; } r -= CI_PW2;
    transpose_job(r, AIN(19) + (size_t)l * 256 * 512, 256, 512, 512, (bf16_t*)(wl + WL_GLU), 0, nullptr, 3, scr, lane);
}
constexpr int CI_D0 = CI_FFI + CI_FFO, CI_DTOT = CI_D0 + CI_DEFER, CI_DSPLIT = CI_D0 + 3000;
__device__ __forceinline__ void convert_deferred(LAS unsigned char* lds, unsigned char* ws, int d, LAS float* scr, int lane) {
    if (d < CI_D0) convert_item(lds, ws, 0, CI_KV1 + d, scr, lane);
    else { const int it = d - CI_D0; convert_item(lds, ws, 1, it < CI_KV0 ? it : it + 2 * CI_SQ, scr, lane); }
}
__device__ __forceinline__ void prologue(const KArgs& a, LAS unsigned char* lds, int gw, int NGW, int wave, int lane) {
    unsigned char* ws = a.ws;
    LAS float* scr = (LAS float*)(lds + wave * 16384);
    { float* ss = (float*)(ws + WS_SS); for (int i = gw * 64 + lane; i < 11 * M; i += NGW * 64) ss[M + i] = 0.f; }
    { float* sq = (float*)(ws + WS_SSQ); for (int i = gw * 64 + lane; i < 8 * M; i += NGW * 64) sq[i] = 0.f; }
    for (int it = gw; it < (CI_NIT - CI_D0) + 2 * CI_SQ; it += NGW) {
        if (it < CI_KV1) convert_item(lds, ws, 0, it, scr, lane);
        else if (it < CI_NIT - CI_D0) convert_item(lds, ws, 0, it + CI_D0, scr, lane);
        else convert_item(lds, ws, 1, CI_KV0 + (it - (CI_NIT - CI_D0)), scr, lane);
    }
    for (int r = gw; r < M + BATCH * NMEM; r += NGW) {
        const bool isx = r < M;
        const float* src = isx ? a.in[0] + (size_t)r * DM : a.in[1] + (size_t)(r - M) * DM;
        f32x4 v[4]; float s = 0.f;
#pragma unroll
        for (int j = 0; j < 4; ++j) { v[j] = *(const f32x4*)(src + 256 * j + 4 * lane); s += (v[j].x * v[j].x + v[j].y * v[j].y) + (v[j].z * v[j].z + v[j].w * v[j].w); }
        s = wave_sum(s);
        float sc = 1.f; bf16_t* dst;
        if (isx) { if (lane == 0) ((float*)(ws + WS_SS))[r] = s; dst = (bf16_t*)(ws + WS_XB) + (size_t)r * DM; }
        else { sc = __builtin_amdgcn_rsqf(s * (1.f / 1024.f) + EPS); dst = (bf16_t*)(ws + WS_HMN) + (size_t)(r - M) * DM; }
#pragma unroll
        for (int j = 0; j < 4; ++j) { u32x2 w; w.x = cvt_pk_bf16(v[j].x * sc, v[j].y * sc); w.y = cvt_pk_bf16(v[j].z * sc, v[j].w * sc); *(u32x2*)(dst + 256 * j + 4 * lane) = w; }
    }
}

__device__ __forceinline__ void sb_task(int task, const bf16_t* Q, const bf16_t* Kb, const bf16_t* Vt, bf16_t* MIX, float* ss_sb, int lane, bool do_atomic = true) {
    const int r32 = lane & 31, hi = lane >> 5;
    const int qb = task & 255, h = (task >> 8) & 7, b = task >> 11;
    const size_t rowbase = (size_t)b * SEQ; const int q0 = qb * 32;
    bf16x8 qf[4];
    { const bf16_t* qp = Q + (rowbase + q0 + r32) * 512 + h * 64 + hi * 8;
#pragma unroll
      for (int ks = 0; ks < 4; ++ks) qf[ks] = *(const bf16x8*)(qp + ks * 16); }
    f32x16 o0, o1;
#pragma unroll
    for (int r = 0; r < 16; ++r) { o0[r] = 0.f; o1[r] = 0.f; }
    float R = 0.f;
    const bf16_t* vt = Vt + (size_t)(b * 8 + h) * 64 * SEQ;
    for (int k0 = q0; k0 >= 0; k0 -= 32) {
        const bf16_t* kp = Kb + (rowbase + k0 + r32) * 512 + h * 64 + hi * 8;
        bf16x8 kf[4];
#pragma unroll
        for (int ks = 0; ks < 4; ++ks) kf[ks] = *(const bf16x8*)(kp + ks * 16);
        s16x4 vlo[2][2], vhi[2][2];
#pragma unroll
        for (int j = 0; j < 2; ++j)
#pragma unroll
            for (int db = 0; db < 2; ++db) { const bf16_t* vp = vt + (size_t)(32 * db + r32) * SEQ + k0 + 16 * j + 4 * hi; vlo[j][db] = *(const s16x4*)vp; vhi[j][db] = *(const s16x4*)(vp + 8); }
        f32x16 s;
#pragma unroll
        for (int r = 0; r < 16; ++r) s[r] = 0.f;
#pragma unroll
        for (int ks = 0; ks < 4; ++ks) s = MFMA32(kf[ks], qf[ks], s);
        const bool diag = (k0 == q0);
        float Lr[16];
#pragma unroll
        for (int r = 0; r < 16; ++r) {
            const float z = s[r];
            float Lv = fminf(-z, 0.f) - lg2(1.f + ex2(-fabsf(z)));
            if (diag && crow(r, hi) >= r32) Lv = 0.f;
            Lr[r] = Lv;
        }
        float tot[4], oth[4], pr[4];
#pragma unroll
        for (int G = 0; G < 4; ++G) { Lr[4 * G + 2] += Lr[4 * G + 3]; Lr[4 * G + 1] += Lr[4 * G + 2]; Lr[4 * G] += Lr[4 * G + 1]; tot[G] = Lr[4 * G]; }
#pragma unroll
        for (int G = 0; G < 4; ++G) { oth[G] = xshfl<32>(tot[G]); pr[G] = tot[G] + oth[G]; }
        float off[4];
        { const float sp3 = 0.f, sp2 = pr[3], sp1 = sp2 + pr[2], sp0 = sp1 + pr[1];
          off[3] = sp3 + R; off[2] = sp2 + R; off[1] = sp1 + R; off[0] = sp0 + R;
          if (hi == 0) { off[0] += oth[0]; off[1] += oth[1]; off[2] += oth[2]; off[3] += oth[3]; }
          R += sp0 + pr[0]; }
        float w[16];
#pragma unroll
        for (int r = 0; r < 16; ++r) { float wv = ex2(s[r] + Lr[r] + off[r >> 2]); if (diag && crow(r, hi) >= r32) wv = 0.f; w[r] = wv; }
        bf16x8 pa[2];
#pragma unroll
        for (int j = 0; j < 2; ++j) { u32x4 p; p.x = cvt_pk_bf16(w[8 * j], w[8 * j + 1]); p.y = cvt_pk_bf16(w[8 * j + 2], w[8 * j + 3]); p.z = cvt_pk_bf16(w[8 * j + 4], w[8 * j + 5]); p.w = cvt_pk_bf16(w[8 * j + 6], w[8 * j + 7]); pa[j] = __builtin_bit_cast(bf16x8, p); }
#pragma unroll
        for (int j = 0; j < 2; ++j) {
            const bf16x8 v0 = (bf16x8){vlo[j][0][0], vlo[j][0][1], vlo[j][0][2], vlo[j][0][3], vhi[j][0][0], vhi[j][0][1], vhi[j][0][2], vhi[j][0][3]};
            const bf16x8 v1 = (bf16x8){vlo[j][1][0], vlo[j][1][1], vlo[j][1][2], vlo[j][1][3], vhi[j][1][0], vhi[j][1][1], vhi[j][1][2], vhi[j][1][3]};
            o0 = MFMA32(pa[j], v0, o0); o1 = MFMA32(pa[j], v1, o1);
        }
        if (__all(R < -34.f)) break;
    }
#pragma unroll
    for (int r = 0; r < 16; ++r) {
        const size_t row = rowbase + q0 + crow(r, hi);
        MIX[row * 1024 + h * 64 + r32] = f2bf(o0[r]);
        MIX[row * 1024 + h * 64 + 32 + r32] = f2bf(o1[r]);
        float ss = o0[r] * o0[r] + o1[r] * o1[r];
        ss += xshfl<1>(ss); ss += xshfl<2>(ss); ss += xshfl<4>(ss); ss += xshfl<8>(ss); ss += xshfl<16>(ss);
        if (r32 == 0 && do_atomic) atomicAdd(ss_sb + row, ss);
    }
}

__device__ __forceinline__ void conv_task(int task, const bf16_t* HC, const LAS float* wlds, const float* dw_b, const float* ln_g, const float* ln_b, bf16_t* AC, int lane) {
    const int row0 = task * 4, t0 = row0 & (SEQ - 1);
    float acc[4][4];
    { const f32x4 bv = *(const f32x4*)(dw_b + 4 * lane);
#pragma unroll
      for (int tt = 0; tt < 4; ++tt) { acc[tt][0] = bv.x; acc[tt][1] = bv.y; acc[tt][2] = bv.z; acc[tt][3] = bv.w; } }
    u32x2 hv[34];
#pragma unroll
    for (int rr = 0; rr < 34; ++rr) {
        const int t = t0 - 30 + rr;
        u32x2 w = (u32x2){0u, 0u};
        if (t >= 0) w = *(const u32x2*)(HC + (size_t)(row0 - 30 + rr) * 256 + 4 * lane);
        hv[rr] = w;
    }
#pragma unroll
    for (int j = 0; j < 31; ++j) {
        const f32x4 wj = *(const LAS f32x4*)(wlds + j * 256 + 4 * lane);
#pragma unroll
        for (int tt = 0; tt < 4; ++tt) {
            const u32x2 w = hv[tt + j];
            acc[tt][0] += wj.x * bflo(w.x); acc[tt][1] += wj.y * bfhi(w.x); acc[tt][2] += wj.z * bflo(w.y); acc[tt][3] += wj.w * bfhi(w.y);
        }
    }
    const f32x4 gv = *(const f32x4*)(ln_g + 4 * lane), bv2 = *(const f32x4*)(ln_b + 4 * lane);
#pragma unroll
    for (int tt = 0; tt < 4; ++tt) {
        const float mean = wave_sum((acc[tt][0] + acc[tt][1]) + (acc[tt][2] + acc[tt][3])) * (1.f / 256.f);
        const float d0 = acc[tt][0] - mean, d1 = acc[tt][1] - mean, d2 = acc[tt][2] - mean, d3 = acc[tt][3] - mean;
        const float var = wave_sum((d0 * d0 + d1 * d1) + (d2 * d2 + d3 * d3)) * (1.f / 256.f);
        const float rstd = __builtin_amdgcn_rsqf(var + EPS);
        float y0 = d0 * rstd * gv.x + bv2.x, y1 = d1 * rstd * gv.y + bv2.y, y2 = d2 * rstd * gv.z + bv2.z, y3 = d3 * rstd * gv.w + bv2.w;
        y0 *= sigmoidf_(y0); y1 *= sigmoidf_(y1); y2 *= sigmoidf_(y2); y3 *= sigmoidf_(y3);
        u32x2 w; w.x = cvt_pk_bf16(y0, y1); w.y = cvt_pk_bf16(y2, y3);
        *(u32x2*)(AC + (size_t)(row0 + tt) * 256 + 4 * lane) = w;
    }
}

struct SsmW { const float *lam_re, *lam_im, *log_dt, *b_re, *b_im, *c_re, *c_im, *dsk; };
__device__ __forceinline__ u32x4 pack8(const float* v) { u32x4 w; w.x = cvt_pk_bf16(v[0], v[1]); w.y = cvt_pk_bf16(v[2], v[3]); w.z = cvt_pk_bf16(v[4], v[5]); w.w = cvt_pk_bf16(v[6], v[7]); return w; }
template <bool PASSC>
__device__ __forceinline__ void ssm_task(int task, const SsmW& W, const bf16_t* U, f32x2* SST, bf16_t* YS, LAS unsigned char* wl, int lane) {
    const int g = (task >> 7) & 15, b = task >> 11;
    const int c = b ? 127 - (task & 127) : (task & 127);
    const size_t tok0 = (size_t)b * SEQ + c * 64;
    LAS unsigned char* BU = wl;
    LAS unsigned char* xb = wl + 8320;
    const int hh = lane & 15, kq = lane >> 4;
    const float lr = W.lam_re[g * 64 + lane], li = W.lam_im[g * 64 + lane], dt = __expf(W.log_dt[g]);
    const float mag = __expf(lr * dt);
    float sn, cs; { const float ang = li * dt; const float kk = rintf(ang * 0.15915494309189535f); float rr = fmaf(-kk, 6.28125f, ang); rr = fmaf(-kk, 1.9353071795864769e-3f, rr); sn = __sinf(rr); cs = __cosf(rr); }
    const float ar = mag * cs, ai = mag * sn;
    const float den = lr * lr + li * li;
    const float fr = ((ar - 1.f) * lr + ai * li) / den, fi = (ai * lr - (ar - 1.f) * li) / den;
    {
        float bbr[16], bbi[16];
        const f32x4* brp = (const f32x4*)(W.b_re + (size_t)(g * 64 + lane) * 16); const f32x4* bip = (const f32x4*)(W.b_im + (size_t)(g * 64 + lane) * 16);
#pragma unroll
        for (int q = 0; q < 4; ++q) { const f32x4 br = brp[q], bi = bip[q];
#pragma unroll
            for (int j = 0; j < 4; ++j) { bbr[4 * q + j] = fr * br[j] - fi * bi[j]; bbi[4 * q + j] = fr * bi[j] + fi * br[j]; } }
        LAS u32x4* t = (LAS u32x4*)(BU + lane * 64);
        t[0] = pack8(bbr); t[1] = pack8(bbr + 8); t[2] = pack8(bbi); t[3] = pack8(bbi + 8);
    }
    asm volatile("s_waitcnt lgkmcnt(0)" ::: "memory");
    const bf16x8 zfrag = (bf16x8){0, 0, 0, 0, 0, 0, 0, 0};
    bf16x8 bfr[8];
#pragma unroll
    for (int nb = 0; nb < 8; ++nb) bfr[nb] = (kq < 2) ? *(const LAS bf16x8*)(BU + (16 * nb + hh) * 32 + kq * 16) : zfrag;
    bf16x8 cf[4];
    if (PASSC) {
#pragma unroll
        for (int ks = 0; ks < 4; ++ks) {
            const int p0 = 16 * ks + 4 * kq;
            const f32x4 cre = *(const f32x4*)(W.c_re + (size_t)(g * 16 + hh) * 64 + p0), cim = *(const f32x4*)(W.c_im + (size_t)(g * 16 + hh) * 64 + p0);
            u32x4 cw; cw.x = cvt_pk_bf16(cre[0], -cim[0]); cw.y = cvt_pk_bf16(cre[1], -cim[1]); cw.z = cvt_pk_bf16(cre[2], -cim[2]); cw.w = cvt_pk_bf16(cre[3], -cim[3]);
            cf[ks] = __builtin_bit_cast(bf16x8, cw);
        }
    }
    float xr = 0.f, xi = 0.f;
    if (PASSC) {
        float tr = ar, ti = ai;
#pragma unroll
        for (int i = 0; i < 6; ++i) { const float nr = tr * tr - ti * ti, ni = 2.f * tr * ti; tr = nr; ti = ni; }
        const f32x2* sl = SST + lane;
        const size_t POFF = (WS_XL - WS_SST) / sizeof(f32x2), so = (size_t)(b * 16 + g) * 128 * 64, po = POFF + (size_t)(b * 16 + g) * 64 * 64;
        const int np = c >> 1; const float tr2 = tr * tr - ti * ti, ti2 = 2.f * tr * ti;
        for (int j0 = 0; j0 < np; j0 += 16) {
            f32x2 sv[16];
#pragma unroll
            for (int q = 0; q < 16; ++q) sv[q] = (j0 + q < np) ? sl[po + (size_t)(j0 + q) * 64] : (f32x2){0.f, 0.f};
#pragma unroll
            for (int q = 0; q < 16; ++q) if (j0 + q < np) { const float nr = tr2 * xr - ti2 * xi + sv[q].x, ni = tr2 * xi + ti2 * xr + sv[q].y; xr = nr; xi = ni; }
        }
        if (c & 1) { const f32x2 s = sl[so + (size_t)(c - 1) * 64]; const float nr = tr * xr - ti * xi + s.x, ni = tr * xi + ti * xr + s.y; xr = nr; xi = ni; }
    }
    const float dk = PASSC ? W.dsk[g * 16 + hh] : 0.f;
    asm volatile("s_waitcnt lgkmcnt(0)" ::: "memory");
#pragma unroll 1
    for (int blk = 0; blk < 4; ++blk) {
        const bf16_t* ub = U + (tok0 + blk * 16) * 256 + g * 16;
        bf16x8 af = zfrag;
        if (kq < 2) af = *(const bf16x8*)(ub + (size_t)hh * 256 + kq * 8);
#pragma unroll
        for (int nb = 0; nb < 8; ++nb) {
            const f32x4 d = MFMA16(af, bfr[nb], ((f32x4){0.f, 0.f, 0.f, 0.f}));
#pragma unroll
            for (int i = 0; i < 4; ++i) *(LAS float*)(BU + (4 * kq + i) * 520 + (16 * nb + hh) * 4) = d[i];
        }
        asm volatile("s_waitcnt lgkmcnt(0)" ::: "memory");
#pragma unroll
        for (int s = 0; s < 16; ++s) {
            const f32x2 bu = *(const LAS f32x2*)(BU + s * 520 + 8 * lane);
            const float nr = ar * xr - ai * xi + bu.x, ni = ar * xi + ai * xr + bu.y; xr = nr; xi = ni;
            if (PASSC) *(LAS unsigned*)(xb + s * 272 + 4 * lane) = cvt_pk_bf16(xr, xi);
        }
        if (PASSC) {
            asm volatile("s_waitcnt lgkmcnt(0)" ::: "memory");
            f32x4 y = (f32x4){0.f, 0.f, 0.f, 0.f};
#pragma unroll
            for (int ks = 0; ks < 4; ++ks) { const bf16x8 a0 = *(const LAS bf16x8*)(xb + hh * 272 + 64 * ks + 16 * kq); y = MFMA16(a0, cf[ks], y); }
#pragma unroll
            for (int i = 0; i < 4; ++i) {
                const size_t e = (size_t)(4 * kq + i) * 256 + hh;
                YS[(tok0 + blk * 16) * 256 + g * 16 + e] = f2bf(y[i] + dk * bf2f(ub[e]));
            }
        }
        asm volatile("s_waitcnt lgkmcnt(0)" ::: "memory");
    }
    if (!PASSC) SST[((size_t)(b * 16 + g) * 128 + c) * 64 + lane] = (f32x2){xr, xi};
}

template <bool PASSC>
__device__ __forceinline__ void ssm_task_old(int task, const SsmW& W, const bf16_t* U, f32x2* SST, bf16_t* YS, LAS unsigned char* wl, int lane) {
    const int c = PASSC ? (task & 127) : 2 * (task & 63) + (task >> 11), g = PASSC ? (task >> 7) & 15 : (task >> 6) & 15, b = PASSC ? task >> 11 : (task >> 10) & 1;
    const size_t tok0 = (size_t)b * SEQ + c * 64;
    LAS float* uL = (LAS float*)wl;
    LAS unsigned char* xb = wl + 4096;
    {
        const u32x4* up = (const u32x4*)(U + (tok0 + lane) * 256 + g * 16);
        const u32x4 w0 = up[0], w1 = up[1];
        LAS f32x4* d = (LAS f32x4*)(uL + lane * 16);
        d[0] = (f32x4){bflo(w0.x), bfhi(w0.x), bflo(w0.y), bfhi(w0.y)}; d[1] = (f32x4){bflo(w0.z), bfhi(w0.z), bflo(w0.w), bfhi(w0.w)};
        d[2] = (f32x4){bflo(w1.x), bfhi(w1.x), bflo(w1.y), bfhi(w1.y)}; d[3] = (f32x4){bflo(w1.z), bfhi(w1.z), bflo(w1.w), bfhi(w1.w)};
    }
    const float lr = W.lam_re[g * 64 + lane], li = W.lam_im[g * 64 + lane], dt = __expf(W.log_dt[g]);
    const float mag = __expf(lr * dt);
    float sn, cs; { const float ang = li * dt; const float kq = rintf(ang * 0.15915494309189535f); float rr = fmaf(-kq, 6.28125f, ang); rr = fmaf(-kq, 1.9353071795864769e-3f, rr); sn = __sinf(rr); cs = __cosf(rr); }
    const float ar = mag * cs, ai = mag * sn;
    const float den = lr * lr + li * li;
    const float fr = ((ar - 1.f) * lr + ai * li) / den, fi = (ai * lr - (ar - 1.f) * li) / den;
    float bbr[16], bbi[16];
    { const f32x4* brp = (const f32x4*)(W.b_re + (size_t)(g * 64 + lane) * 16); const f32x4* bip = (const f32x4*)(W.b_im + (size_t)(g * 64 + lane) * 16);
#pragma unroll
      for (int q = 0; q < 4; ++q) { const f32x4 br = brp[q], bi = bip[q];
#pragma unroll
          for (int j = 0; j < 4; ++j) { bbr[4 * q + j] = fr * br[j] - fi * bi[j]; bbi[4 * q + j] = fr * bi[j] + fi * br[j]; } } }
    float xr = 0.f, xi = 0.f;
    if (PASSC) {
        float tr = ar, ti = ai;
#pragma unroll
        for (int i = 0; i < 6; ++i) { const float nr = tr * tr - ti * ti, ni = 2.f * tr * ti; tr = nr; ti = ni; }
        const f32x2* sp = SST + ((size_t)(b * 16 + g) * 128) * 64 + lane;
        for (int j0 = 0; j0 < c; j0 += 16) {
            f32x2 sv[16];
#pragma unroll
            for (int q = 0; q < 16; ++q) sv[q] = (j0 + q < c) ? sp[(size_t)(j0 + q) * 64] : (f32x2){0.f, 0.f};
#pragma unroll
            for (int q = 0; q < 16; ++q) if (j0 + q < c) { const float nr = tr * xr - ti * xi + sv[q].x, ni = tr * xi + ti * xr + sv[q].y; xr = nr; xi = ni; }
        }
    }
    asm volatile("s_waitcnt lgkmcnt(0)" ::: "memory");
#pragma unroll 1
    for (int half = 0; half < 2; ++half) {
#pragma unroll 4
        for (int s = 0; s < 32; ++s) {
            const LAS f32x4* ur = (const LAS f32x4*)(uL + (half * 32 + s) * 16);
            float br_ = 0.f, bi_ = 0.f;
#pragma unroll
            for (int q = 0; q < 4; ++q) { const f32x4 uv = ur[q];
#pragma unroll
                for (int j = 0; j < 4; ++j) { br_ = fmaf(bbr[4 * q + j], uv[j], br_); bi_ = fmaf(bbi[4 * q + j], uv[j], bi_); } }
            const float nr = ar * xr - ai * xi + br_, ni = ar * xi + ai * xr + bi_; xr = nr; xi = ni;
            if (PASSC) *(LAS unsigned*)(xb + s * 272 + 4 * lane) = cvt_pk_bf16(xr, xi);
        }
        if (PASSC) {
            asm volatile("s_waitcnt lgkmcnt(0)" ::: "memory");
            const int hh = lane & 15, kq = lane >> 4;
            f32x4 y0 = (f32x4){0.f, 0.f, 0.f, 0.f}, y1 = y0;
#pragma unroll
            for (int ks = 0; ks < 4; ++ks) {
                const int p0 = 16 * ks + 4 * kq;
                const f32x4 cre = *(const f32x4*)(W.c_re + (size_t)(g * 16 + hh) * 64 + p0), cim = *(const f32x4*)(W.c_im + (size_t)(g * 16 + hh) * 64 + p0);
                u32x4 cw; cw.x = cvt_pk_bf16(cre[0], -cim[0]); cw.y = cvt_pk_bf16(cre[1], -cim[1]); cw.z = cvt_pk_bf16(cre[2], -cim[2]); cw.w = cvt_pk_bf16(cre[3], -cim[3]);
                const bf16x8 cf = __builtin_bit_cast(bf16x8, cw);
                const bf16x8 a0 = *(const LAS bf16x8*)(xb + (lane & 15) * 272 + 64 * ks + 16 * kq);
                const bf16x8 a1 = *(const LAS bf16x8*)(xb + (16 + (lane & 15)) * 272 + 64 * ks + 16 * kq);
                y0 = MFMA16(a0, cf, y0); y1 = MFMA16(a1, cf, y1);
            }
            const float dk = W.dsk[g * 16 + hh];
#pragma unroll
            for (int i = 0; i < 4; ++i) {
                const int s0 = 4 * kq + i, s1 = 16 + 4 * kq + i;
                const float v0 = y0[i] + dk * uL[(half * 32 + s0) * 16 + hh], v1 = y1[i] + dk * uL[(half * 32 + s1) * 16 + hh];
                YS[(tok0 + half * 32 + s0) * 256 + g * 16 + hh] = f2bf(v0);
                YS[(tok0 + half * 32 + s1) * 256 + g * 16 + hh] = f2bf(v1);
            }
            asm volatile("s_waitcnt lgkmcnt(0)" ::: "memory");
        }
    }
    if (!PASSC) {
        f32x2* sp = SST + ((size_t)(b * 16 + g) * 128 + c) * 64 + lane;
        *sp = (f32x2){xr, xi};
        if ((c & 1) && launder_i(1)) {
            asm volatile("s_waitcnt vmcnt(0)" ::: "memory");
            const f32x2 s0 = *(sp - 64);
            float tr = ar, ti = ai;
#pragma unroll
            for (int i = 0; i < 6; ++i) { const float nr = tr * tr - ti * ti, ni = 2.f * tr * ti; tr = nr; ti = ni; }
            ((f32x2*)((unsigned char*)SST + (WS_XL - WS_SST)))[((size_t)(b * 16 + g) * 64 + (c >> 1)) * 64 + lane] = (f32x2){tr * s0.x - ti * s0.y + xr, tr * s0.y + ti * s0.x + xi};
        }
    }
}

__device__ __forceinline__ void knorm_task(int task, const float* kraw, const float* kg_all, const float* qg_all, bf16_t* KP, int lane) {
    const int head = task & 3, row = (task >> 2) & 511, lay = task >> 11;
    const f32x4 v = *(const f32x4*)(kraw + ((size_t)lay * 512 + row) * 1024 + head * 256 + 4 * lane);
    const float ss = wave_sum((v.x * v.x + v.y * v.y) + (v.z * v.z + v.w * v.w));
    const float rs = __builtin_amdgcn_rsqf(ss * (1.f / 256.f) + EPS);
    const f32x4 kg = *(const f32x4*)(kg_all + lay * 256 + 4 * lane), qg = *(const f32x4*)(qg_all + lay * 256 + 4 * lane);
    const int b = row >> 8, mt = row & 255;
    u32x2 w; w.x = cvt_pk_bf16(v.x * rs * kg.x * qg.x, v.y * rs * kg.y * qg.y); w.y = cvt_pk_bf16(v.z * rs * kg.z * qg.z, v.w * rs * kg.w * qg.w);
    *(u32x2*)(KP + ((size_t)((lay * 2 + b) * 4 + head) * 256 + mt) * 256 + 4 * lane) = w;
}

__device__ __forceinline__ void xa_task(int task, const bf16_t* XQ, const bf16_t* KPl, const bf16_t* VTMl, bf16_t* XO, int lane) {
    const int r32 = lane & 31, hi = lane >> 5;
    const int qb = task & 255, head = (task >> 8) & 3, b = task >> 10;
    const size_t rowbase = (size_t)b * SEQ; const int q0 = qb * 32;
    float ssq = 0.f;
    const bf16_t* qp = XQ + (rowbase + q0 + r32) * 1024 + head * 256 + hi * 8;
#pragma unroll
    for (int ks = 0; ks < 16; ++ks) { const bf16x8 qv = *(const bf16x8*)(qp + ks * 16);
#pragma unroll
        for (int j = 0; j < 8; ++j) { const float f = bf2f((unsigned short)qv[j]); ssq += f * f; } }
    ssq += xshfl<32>(ssq);
    const float rq = __builtin_amdgcn_rsqf(ssq * (1.f / 256.f) + EPS) * (0.0625f * LOG2E);
    const bf16_t* kbase = KPl + ((size_t)(b * 4 + head) * 256 + r32) * 256 + hi * 8;
    f32x16 sc[8];
#pragma unroll
    for (int kb = 0; kb < 8; ++kb) {
        f32x16 s;
#pragma unroll
        for (int r = 0; r < 16; ++r) s[r] = 0.f;
#pragma unroll
        for (int ks = 0; ks < 16; ++ks) { const bf16x8 kf = *(const bf16x8*)(kbase + (size_t)kb * 32 * 256 + ks * 16); const bf16x8 qv = *(const bf16x8*)(qp + ks * 16); s = MFMA32(kf, qv, s); }
        sc[kb] = s * rq;
        asm volatile("" ::: "memory");
    }
    float mx = -3.0e38f;
#pragma unroll
    for (int kb = 0; kb < 8; ++kb)
#pragma unroll
        for (int r = 0; r < 16; ++r) mx = fmaxf(mx, sc[kb][r]);
    mx = fmaxf(mx, xshfl<32>(mx));
    float sum = 0.f;
#pragma unroll
    for (int kb = 0; kb < 8; ++kb)
#pragma unroll
        for (int r = 0; r < 16; ++r) { const float p = ex2(sc[kb][r] - mx); sc[kb][r] = p; sum += p; }
    sum += xshfl<32>(sum);
    const float inv = __builtin_amdgcn_rcpf(sum);
    bf16x8 pa[8][2];
#pragma unroll
    for (int kb = 0; kb < 8; ++kb)
#pragma unroll
        for (int j = 0; j < 2; ++j) { u32x4 p; p.x = cvt_pk_bf16(sc[kb][8 * j] * inv, sc[kb][8 * j + 1] * inv); p.y = cvt_pk_bf16(sc[kb][8 * j + 2] * inv, sc[kb][8 * j + 3] * inv);
            p.z = cvt_pk_bf16(sc[kb][8 * j + 4] * inv, sc[kb][8 * j + 5] * inv); p.w = cvt_pk_bf16(sc[kb][8 * j + 6] * inv, sc[kb][8 * j + 7] * inv); pa[kb][j] = __builtin_bit_cast(bf16x8, p); }
    const bf16_t* vbase = VTMl + ((size_t)(b * 4 + head) * 256 + r32) * 256 + 4 * hi;
#pragma unroll 1
    for (int db = 0; db < 8; ++db) {
        f32x16 o;
#pragma unroll
        for (int r = 0; r < 16; ++r) o[r] = 0.f;
        const bf16_t* vp = vbase + (size_t)db * 32 * 256;
#pragma unroll
        for (int kb = 0; kb < 8; ++kb)
#pragma unroll
            for (int j = 0; j < 2; ++j) {
                const s16x4 lo = *(const s16x4*)(vp + kb * 32 + 16 * j), hi4 = *(const s16x4*)(vp + kb * 32 + 16 * j + 8);
                const bf16x8 vf = (bf16x8){lo[0], lo[1], lo[2], lo[3], hi4[0], hi4[1], hi4[2], hi4[3]};
                o = MFMA32(pa[kb][j], vf, o);
            }
#pragma unroll
        for (int r = 0; r < 16; ++r) XO[(rowbase + q0 + crow(r, hi)) * 1024 + head * 256 + db * 32 + r32] = f2bf(o[r]);
    }
}

#define XB_TMO      128
#define XB_XCNT(j)  (256  + 64 * (j))
#define XB_XSUB(j)  (1280 + 64 * (j))
#define XB_XGEN(j)  (2304 + 64 * (j))
#define XB_TOP      3328
#define XB_TOPGEN   3392
#define XCD_BAR_WORDS 3456
#define XB_SPIN_CAP (1u << 18)

__device__ __forceinline__ unsigned xb_ld(unsigned* p)              { return __hip_atomic_load(p, __ATOMIC_RELAXED, __HIP_MEMORY_SCOPE_AGENT); }
__device__ __forceinline__ unsigned xb_add(unsigned* p, unsigned v) { return __hip_atomic_fetch_add(p, v, __ATOMIC_RELAXED, __HIP_MEMORY_SCOPE_AGENT); }
__device__ __forceinline__ unsigned xb_xcc_id() { return (unsigned)__builtin_amdgcn_s_getreg((3 << 11) | 20) & 0xFu; }
#define XB_SPIN(cond, bar) do { unsigned _sp = 0; while (cond) { __builtin_amdgcn_s_sleep(1); \
    if ((++_sp & 255u) == 0u) { if (xb_ld(&(bar)[XB_TMO])) break; if (_sp > XB_SPIN_CAP) { atomicAdd(&(bar)[XB_TMO], 1u); break; } } } } while (0)

struct XcdBarrier {
    unsigned* bar; unsigned x;
    volatile LAS unsigned* st;
};

__device__ __forceinline__ XcdBarrier xcd_barrier_post(unsigned* bar, volatile LAS unsigned* st) {
    XcdBarrier b; b.bar = bar; b.x = xb_xcc_id(); b.st = st;
    if (threadIdx.x == 0) (void)xb_add(&bar[XB_XCNT(b.x)], 1u);
    return b;
}
__device__ __forceinline__ void xcd_barrier_complete(unsigned* bar, unsigned x, unsigned& nloc, unsigned& nx) {
    const unsigned G = gridDim.x * gridDim.y * gridDim.z;
    unsigned sum, cnt, mine, sp = 0u;
    for (;;) {
        sum = 0u; cnt = 0u; mine = 0u;
#pragma unroll
        for (unsigned j = 0; j < 16; ++j) { const unsigned c = xb_ld(&bar[XB_XCNT(j)]); sum += c; cnt += (c > 0u) ? 1u : 0u; mine = (j == x) ? c : mine; }
        if (sum == G) break;
        __builtin_amdgcn_s_sleep(1);
        if ((++sp & 255u) == 0u) { if (xb_ld(&bar[XB_TMO])) break; if (sp > XB_SPIN_CAP) { atomicAdd(&bar[XB_TMO], 1u); break; } }
    }
    nloc = mine > 0u ? mine : 1u; nx = cnt > 0u ? cnt : 1u;
}

__device__ __forceinline__ void xcd_barrier(const XcdBarrier& b) {
    asm volatile("s_waitcnt vmcnt(0)" ::: "memory");
    __syncthreads();
    if (threadIdx.x == 0) {
        unsigned* bar = b.bar;
        unsigned bx = (unsigned)__builtin_amdgcn_readfirstlane((int)b.x); asm volatile("" : "+s"(bx));
        __builtin_amdgcn_s_waitcnt(0);
        unsigned nloc = b.st[0], nx = b.st[1];
        if (nloc == 0u) { xcd_barrier_complete(bar, bx, nloc, nx); b.st[0] = nloc; b.st[1] = nx; }
        const unsigned old = xb_add(&bar[XB_XSUB(bx)], 1u);
        const unsigned gen = old / nloc;
        if (old + 1u == (gen + 1u) * nloc) {
            __builtin_amdgcn_fence(__ATOMIC_RELEASE, "agent");
            asm volatile("s_waitcnt vmcnt(0)" ::: "memory");
            const unsigned og = xb_add(&bar[XB_TOP], 1u);
            const unsigned tg = og / nx;
            if (og + 1u == (tg + 1u) * nx) xb_add(&bar[XB_TOPGEN], 1u);
            else XB_SPIN(xb_ld(&bar[XB_TOPGEN]) == tg, bar);
            __builtin_amdgcn_fence(__ATOMIC_ACQUIRE, "agent");
            xb_add(&bar[XB_XGEN(bx)], 1u);
            asm volatile("s_waitcnt vmcnt(0)" ::: "memory");
        } else {
            XB_SPIN(xb_ld(&bar[XB_XGEN(bx)]) == gen, bar);
            __builtin_amdgcn_fence(__ATOMIC_ACQUIRE, "agent");
            asm volatile("s_waitcnt vmcnt(0)" ::: "memory");
        }
    }
    __syncthreads();
}


#ifndef REP_SYNC
#define REP_SYNC 0
#endif
#ifndef REP_PRO
#define REP_PRO 0
#endif
#ifndef REP_XA
#define REP_XA 0
#endif
#ifndef REP_SB
#define REP_SB 0
#endif
#ifndef REP_CONV
#define REP_CONV 0
#endif
#ifndef REP_SSMA
#define REP_SSMA 0
#endif
#ifndef REP_PA
#define REP_PA 0
#endif
#ifndef REP_PJ
#define REP_PJ 0
#endif
#ifndef REP_PC
#define REP_PC 0
#endif
#define GSYNC() do { xcd_barrier(xbar); for (int r_ = 0; r_ < REP_SYNC; ++r_) xcd_barrier(xbar); } while (0)
__global__ void __launch_bounds__(NWAVES * 64, 2) fwd_kernel(KArgs a) {
    extern __shared__ __attribute__((aligned(16))) unsigned char lds_raw[];
    LAS unsigned char* lds = (LAS unsigned char*)lds_raw;
    cg::grid_group grid = cg::this_grid();
    const int wave = __builtin_amdgcn_readfirstlane((int)threadIdx.x >> 6);
    const int G = gridDim.x, vcu = (G % 8 == 0) ? ((int)blockIdx.x % 8) * (G / 8) + (int)blockIdx.x / 8 : (int)blockIdx.x;
    const int gw = vcu * NWAVES + wave, NGW = G * NWAVES;
#define PHASE_PTRS() unsigned char* ws = argp(lds, 34); const int ln = lane_id_asm(); int gwl = launder_i(gw); (void)ln; (void)gwl; unsigned char* wl = ws + WS_W + (size_t)l * WL_STRIDE; (void)wl; \
    bf16_t* XB = (bf16_t*)(ws + WS_XB); bf16_t* Qb = (bf16_t*)(ws + WS_Q); bf16_t* Kb = (bf16_t*)(ws + WS_K); bf16_t* Vt = (bf16_t*)(ws + WS_VT); \
    bf16_t* HC = (bf16_t*)(ws + WS_HC); bf16_t* Ub = (bf16_t*)(ws + WS_U); bf16_t* AC = (bf16_t*)(ws + WS_AC); bf16_t* YS = (bf16_t*)(ws + WS_YS); \
    float* KRAW = (float*)(ws + WS_KRAW); bf16_t* HF = (bf16_t*)(ws + WS_HF); bf16_t* MIX = (bf16_t*)(ws + WS_MIX); bf16_t* XO = (bf16_t*)AOUT(); \
    f32x2* SST = (f32x2*)(ws + WS_SST); bf16_t* KP = (bf16_t*)(ws + WS_KP); bf16_t* VTM = (bf16_t*)(ws + WS_VTM); bf16_t* HMN = (bf16_t*)(ws + WS_HMN); \
    (void)XB; (void)Qb; (void)Kb; (void)Vt; (void)HC; (void)Ub; (void)AC; (void)YS; (void)KRAW; (void)HF; (void)MIX; (void)XO; (void)SST; (void)KP; (void)VTM; (void)HMN;

    if (threadIdx.x < 2) ((volatile LAS unsigned*)(lds + XBST_OFF))[threadIdx.x] = 0u;
    __syncthreads();
    XcdBarrier xbar = xcd_barrier_post((unsigned*)(a.ws + WS_BAR), (volatile LAS unsigned*)(lds + XBST_OFF));
    if (threadIdx.x == 0) {
        volatile LAS unsigned long long* ap = (volatile LAS unsigned long long*)(lds + ARGS_OFF);
#pragma unroll
        for (int i = 0; i < 33; ++i) ap[i] = (unsigned long long)a.in[i];
        ap[33] = (unsigned long long)a.out; ap[34] = (unsigned long long)a.ws;
    }
#ifndef SKIP_PRO
    __syncthreads();
    for (int r_ = 0; r_ <= REP_PRO; ++r_) prologue(a, lds, gw, NGW, wave, lane_id_asm());
#endif
    __syncthreads();
    if (a.ws == nullptr) grid.sync();
    GSYNC();

    for (int l = 0; l < DEPTH; ++l) {
        {
            PHASE_PTRS();
            pg8::Sched S; S.A0 = (const char*)XB; S.B0 = (const char*)(wl + WL_IN); S.nM0 = M / 256; S.nN0 = NIN / 256;
            S.A1 = (const char*)HMN; S.B1 = (const char*)(ws + WS_WKV); S.nM1 = 2; S.nN1 = 16; S.np = (l == 0) ? 2 : 1; S.K = DM; S.G = G; S.c = launder_i(blockIdx.x);
            EpiIn E{ws, l, AIN(4) + l * 64, AIN(5) + l * 64};
#if !defined(SKIP_GEMM) && (!defined(GSEL) || (GSEL & 1))
            for (int r_ = 0; r_ < REP_PA; ++r_) pg8::gemm_phase(lds, S, E, wave);
            pg8::gemm_phase(lds, S, E, wave);
#endif
            if (l == 0) {
                const int first = (G > 96) ? 96 : 0, nb = G - first;
                if ((int)blockIdx.x >= first) {
                    const int ln5 = lane_id_asm(); LAS float* scr = (LAS float*)(lds + wave * 16384);
                    for (int d = ((int)blockIdx.x - first) * NWAVES + wave; d < CI_DSPLIT; d += nb * NWAVES) convert_deferred(lds, ws, d, scr, ln5);
                }
            }
        }
        GSYNC();
        {
            PHASE_PTRS();
            #ifndef SKIP_SB
            { const float* dw = AIN(6) + l * 31 * 256; const int tl = wave * 64 + ln;
              for (int i = tl; i < 31 * 64; i += NWAVES * 64) ((LAS f32x4*)lds)[i] = ((const f32x4*)dw)[i];
              __syncthreads(); }
            for (int r_ = 0; r_ <= REP_SB; ++r_) { const int ln1 = lane_id_asm(); for (int t = gwl; t < 4096; t += NGW) sb_task(t, Qb, Kb, Vt, MIX, SSP(l, SS_SB), ln1, r_ == 0); }
#endif
#ifndef SKIP_CONV
            for (int r_ = 0; r_ <= REP_CONV; ++r_) { const int ln2 = lane_id_asm(); for (int t = gwl; t < M / 4; t += NGW) conv_task(t, HC, (const LAS float*)lds, AIN(7) + l * 256, AIN(8) + l * 256, AIN(9) + l * 256, AC, ln2); }
#endif
            __syncthreads();
            SsmW W{AIN(11) + l * 1024, AIN(12) + l * 1024, AIN(13) + l * 16, AIN(14) + (size_t)l * 16384, AIN(15) + (size_t)l * 16384, AIN(16) + (size_t)l * 16384, AIN(17) + (size_t)l * 16384, AIN(18) + l * 256};
#ifndef SKIP_SSM
            for (int r_ = 0; r_ <= REP_SSMA; ++r_) { const int ln3 = lane_id_asm(); for (int t = gwl; t < 4096; t += NGW) ssm_task_old<false>(t, W, Ub, SST, YS, lds + wave * 16384, ln3); }
#endif
            if (l == 0) { const int ln4 = lane_id_asm(); for (int t = gwl; t < 4096; t += NGW) knorm_task(t, KRAW, AIN(28), AIN(27), KP, ln4); }
        }
        GSYNC();
        {
            PHASE_PTRS();
            SsmW W{AIN(11) + l * 1024, AIN(12) + l * 1024, AIN(13) + l * 16, AIN(14) + (size_t)l * 16384, AIN(15) + (size_t)l * 16384, AIN(16) + (size_t)l * 16384, AIN(17) + (size_t)l * 16384, AIN(18) + l * 256};
#ifndef SKIP_SSM
            for (int r_ = 0; r_ <= REP_PC; ++r_) for (int t = gwl; t < 4096; t += NGW) ssm_task<true>(t, W, Ub, SST, YS, lds + wave * 16384, ln);
#endif
        }
        GSYNC();
        {
            PHASE_PTRS();
            pg8::Sched S; S.A0 = (const char*)AC; S.B0 = (const char*)(wl + WL_PW2); S.nM0 = M / 256; S.nN0 = 1;
            S.A1 = (const char*)YS; S.B1 = (const char*)(wl + WL_GLU); S.nM1 = M / 256; S.nN1 = 2; S.np = 2; S.K = 256; S.G = G; S.c = launder_i(blockIdx.x);
            EpiPwGlu E{ws, l};
#if !defined(SKIP_GEMM) && (!defined(GSEL) || (GSEL & 2))
            pg8::gemm_phase(lds, S, E, wave);
#endif
        }
        GSYNC();
        {
            PHASE_PTRS();
            pg8::Sched S; S.A0 = (const char*)MIX; S.B0 = (const char*)(wl + WL_OUT); S.nM0 = M / 256; S.nN0 = 4; S.A1 = nullptr; S.B1 = nullptr; S.nM1 = 0; S.nN1 = 0; S.np = 1; S.K = DM; S.G = G; S.c = launder_i(blockIdx.x);
            EpiRes E{nullptr, ws, l * 6 + SS_XA, (const LAS float*)(lds + EX_OFF)};
            { pg8::Unit u0; const int tl = wave * 64 + ln;
              if (S.next(0, u0) && tl < 256) {
                  const int row = u0.pm * 256 + tl;
                  const float r1 = __builtin_amdgcn_rsqf(SSP(l, SS_SB)[row] * (1.f / 512.f) + EPS), r2 = __builtin_amdgcn_rsqf(SSP(l, SS_CONV)[row] * (1.f / 256.f) + EPS), r3 = __builtin_amdgcn_rsqf(SSP(l, SS_SSM)[row] * (1.f / 256.f) + EPS);
                  LAS float* fac = (LAS float*)(lds + EX_OFF) + tl * 4;
                  fac[0] = r1 / r2; fac[1] = r2 / r3; fac[2] = r3; }
              __syncthreads(); }
#if !defined(SKIP_GEMM) && (!defined(GSEL) || (GSEL & 4))
            pg8::gemm_phase(lds, S, E, wave, pg8::HookMix{(const LAS float*)(lds + EX_OFF)});
#endif
        }
        GSYNC();
        {
            PHASE_PTRS();
            pg8::Sched S; S.A0 = (const char*)XB; S.B0 = (const char*)(wl + WL_Q); S.nM0 = M / 256; S.nN0 = 4; S.A1 = nullptr; S.B1 = nullptr; S.nM1 = 0; S.nN1 = 0; S.np = 1; S.K = DM; S.G = G; S.c = launder_i(blockIdx.x);
            EpiQ E{ws, l};
#if !defined(SKIP_GEMM) && (!defined(GSEL) || (GSEL & 8))
            pg8::gemm_phase(lds, S, E, wave);
#endif
        }
        if (launder_i(G) != 256) { GSYNC(); }
        else {
            asm volatile("s_waitcnt vmcnt(0)" ::: "memory"); __syncthreads();
            if (threadIdx.x == 0) { __builtin_amdgcn_fence(__ATOMIC_ACQUIRE, "agent"); asm volatile("s_waitcnt vmcnt(0)" ::: "memory"); }
            __syncthreads();
        }
        {
            PHASE_PTRS();
            pg8::SchedXA S; S.A = (const char*)MIX; S.B = (const char*)(KP + (size_t)l * 2 * 4 * 256 * 256); S.K = 256; S.G = G; S.c = launder_i(blockIdx.x);
            EpiSm E{ws, l, lds};
#if !defined(SKIP_GEMM)
            pg8::gemm_phase(lds, S, E, wave);
#endif
        }
        asm volatile("s_waitcnt vmcnt(0)" ::: "memory"); __syncthreads();
        if (threadIdx.x == 0) { __builtin_amdgcn_fence(__ATOMIC_ACQUIRE, "agent"); asm volatile("s_waitcnt vmcnt(0)" ::: "memory"); }
        __syncthreads();
        {
            PHASE_PTRS();
            pg8::SchedXA S; S.A = (const char*)HF; S.B = (const char*)(VTM + (size_t)l * 2 * 4 * 256 * 256); S.K = 256; S.G = G; S.c = launder_i(blockIdx.x);
            EpiPlain E{(unsigned char*)AOUT(), 0};
#if !defined(SKIP_GEMM)
            pg8::gemm_phase(lds, S, E, wave);
#endif
        }
        GSYNC();
        {
            PHASE_PTRS();
            pg8::Sched S; S.A0 = (const char*)XO; S.B0 = (const char*)(wl + WL_O); S.nM0 = M / 256; S.nN0 = 4; S.A1 = nullptr; S.B1 = nullptr; S.nM1 = 0; S.nN1 = 0; S.np = 1; S.K = DM; S.G = G; S.c = launder_i(blockIdx.x);
            EpiRes E{nullptr, ws, l * 6 + SS_FFN, nullptr};
#if !defined(SKIP_GEMM) && (!defined(GSEL) || (GSEL & 16))
            pg8::gemm_phase(lds, S, E, wave);
#endif
        }
        GSYNC();
        {
            PHASE_PTRS();
            pg8::Sched S; S.A0 = (const char*)XB; S.B0 = (const char*)(wl + WL_FFI); S.nM0 = M / 256; S.nN0 = 2 * FFH / 256; S.A1 = nullptr; S.B1 = nullptr; S.nM1 = 0; S.nN1 = 0; S.np = 1; S.K = DM; S.G = G; S.c = launder_i(blockIdx.x);
            EpiFfn E{ws, l};
#if !defined(SKIP_GEMM) && (!defined(GSEL) || (GSEL & 32))
            for (int r_ = 0; r_ < REP_PJ; ++r_) pg8::gemm_phase(lds, S, E, wave);
            pg8::gemm_phase(lds, S, E, wave);
#endif
            if (l == 0) {
                const int first = (G > 128) ? 128 : 0, nb = G - first;
                if ((int)blockIdx.x >= first) {
                    const int ln5 = lane_id_asm(); LAS float* scr = (LAS float*)(lds + wave * 16384);
                    for (int d = CI_DSPLIT + ((int)blockIdx.x - first) * NWAVES + wave; d < CI_DTOT; d += nb * NWAVES) convert_deferred(lds, ws, d, scr, ln5);
                }
            }
        }
        GSYNC();
        {
            PHASE_PTRS();
            pg8::Sched S; S.A0 = (const char*)HF; S.B0 = (const char*)(wl + WL_FFO); S.nM0 = M / 256; S.nN0 = 4; S.A1 = nullptr; S.B1 = nullptr; S.nM1 = 0; S.nN1 = 0; S.np = 1; S.K = FFH; S.G = G; S.c = launder_i(blockIdx.x);
            EpiRes E{(l + 1 < DEPTH) ? nullptr : AOUT(), ws, (l + 1 < DEPTH) ? (l + 1) * 6 + SS_MIX : -1, nullptr};
#if !defined(SKIP_GEMM) && (!defined(GSEL) || (GSEL & 64))
            pg8::gemm_phase(lds, S, E, wave);
#endif
        }
        if (l + 1 < DEPTH) GSYNC();
    }
}

constexpr int LDS_BYTES = 147456;

extern "C" void kernel_launch(void* const* d_in, const int* in_sizes, int n_in, void* d_out, int out_size, void* d_ws, size_t ws_size, hipStream_t stream) {
    static int grid = 0;
    if (grid == 0) {
        int dev = 0, cus = 0, per_cu = 0;
        hipGetDevice(&dev);
        hipDeviceGetAttribute(&cus, hipDeviceAttributeMultiprocessorCount, dev);
        hipFuncSetAttribute((const void*)fwd_kernel, hipFuncAttributeMaxDynamicSharedMemorySize, LDS_BYTES);
        hipOccupancyMaxActiveBlocksPerMultiprocessor(&per_cu, (const void*)fwd_kernel, NWAVES * 64, LDS_BYTES);
        (void)hipGetLastError();
        if (per_cu < 1) per_cu = 1;
        grid = cus;
        if (grid <= 0) grid = 256;
    }
    hipMemsetAsync((char*)d_ws + WS_BAR, 0, 16384, stream);
    KArgs a{};
    for (int i = 0; i < 33; ++i) a.in[i] = (const float*)d_in[i];
    a.out = (float*)d_out; a.ws = (unsigned char*)d_ws;
    void* args[] = {&a};
    hipError_t e = hipLaunchCooperativeKernel((const void*)fwd_kernel, dim3(grid), dim3(NWAVES * 64), args, LDS_BYTES, stream);
    if (e != hipSuccess) fprintf(stderr, "cooperative launch failed: %s (grid %d)\n", hipGetErrorString(e), grid);
}
```

```cpp
#include <hip/hip_runtime.h>
#include <hip/hip_cooperative_groups.h>
#include <cstdio>
#include <cstdint>
namespace cg = cooperative_groups;

#define LAS __attribute__((address_space(3)))
typedef unsigned short bf16_t;
typedef short bf16x8 __attribute__((ext_vector_type(8)));
typedef short s16x4 __attribute__((ext_vector_type(4)));
typedef float f32x4 __attribute__((ext_vector_type(4)));
typedef float f32x2 __attribute__((ext_vector_type(2)));
typedef float f32x16 __attribute__((ext_vector_type(16)));
typedef unsigned u32x4 __attribute__((ext_vector_type(4)));
typedef unsigned u32x2 __attribute__((ext_vector_type(2)));

constexpr int BATCH = 2, SEQ = 8192, DM = 1024, M = BATCH * SEQ, DEPTH = 2;
constexpr int NIN = 2304, FFH = 2816, NMEM = 256;
constexpr float EPS = 1e-6f;
constexpr float LOG2E = 1.4426950408889634f;
constexpr int NWAVES = 8;

constexpr size_t MiB = 1u << 20;
constexpr size_t WS_SS = 0;
constexpr size_t WS_BAR = 768 * 1024;
constexpr size_t WS_W = 1 * MiB;
constexpr size_t WL_IN = 0, WL_OUT = 4718592, WL_Q = 6815744, WL_O = 8912896, WL_FFI = 11010048, WL_FFO = 22544384, WL_PW2 = 28311552, WL_GLU = 28442624, WL_STRIDE = 28704768;
constexpr size_t WS_WKV = WS_W + 2 * WL_STRIDE;
constexpr size_t WS_XB = 64 * MiB;
constexpr size_t WS_RA = 96 * MiB;
constexpr size_t WS_Q = WS_RA, WS_K = WS_RA + 16 * MiB, WS_VT = WS_RA + 32 * MiB, WS_HC = WS_RA + 48 * MiB, WS_U = WS_RA + 56 * MiB,
                 WS_AC = WS_RA + 64 * MiB, WS_YS = WS_RA + 72 * MiB, WS_KRAW = WS_RA + 80 * MiB;
constexpr size_t WS_HF = WS_RA;
constexpr size_t WS_MIX = 184 * MiB;
constexpr size_t WS_XL = 216 * MiB;
constexpr size_t WS_SSQ = 255 * MiB;
constexpr size_t WS_SST = 248 * MiB, WS_KP = 250 * MiB, WS_VTM = 252 * MiB, WS_HMN = 254 * MiB;
static_assert(WS_WKV + 2 * 2048 * 1024 * 2 <= WS_XB, "weights fit");

enum { SS_MIX = 0, SS_SB = 1, SS_CONV = 2, SS_SSM = 3, SS_XA = 4, SS_FFN = 5 };

typedef __bf16 bf16x2_t __attribute__((ext_vector_type(2)));
__device__ __forceinline__ unsigned cvt_pk_bf16(float lo, float hi) { f32x2 v = {lo, hi}; bf16x2_t b = __builtin_convertvector(v, bf16x2_t); return __builtin_bit_cast(unsigned, b); }
__device__ __forceinline__ bf16_t f2bf(float f) { unsigned u = __builtin_bit_cast(unsigned, f); return (bf16_t)((u + 0x7fffu + ((u >> 16) & 1u)) >> 16); }
__device__ __forceinline__ float bf2f(unsigned short b) { return __builtin_bit_cast(float, (unsigned)b << 16); }
__device__ __forceinline__ float bflo(unsigned w) { return __builtin_bit_cast(float, w << 16); }
__device__ __forceinline__ float bfhi(unsigned w) { return __builtin_bit_cast(float, w & 0xffff0000u); }
__device__ __forceinline__ float ex2(float x) { return __builtin_amdgcn_exp2f(x); }
__device__ __forceinline__ float lg2(float x) { return __builtin_amdgcn_logf(x); }
__device__ __forceinline__ float sigmoidf_(float x) { return __builtin_amdgcn_rcpf(1.f + ex2(-x * LOG2E)); }
__device__ __forceinline__ int crow(int r, int hi) { return (r & 3) + 8 * (r >> 2) + 4 * hi; }
template <int MASK> __device__ __forceinline__ float xshfl(float v) {
    if constexpr (MASK == 32) {
        const unsigned u = __builtin_bit_cast(unsigned, v);
        auto rr = __builtin_amdgcn_permlane32_swap(u, u, false, false);
        const bool up = (__builtin_amdgcn_mbcnt_hi(~0u, __builtin_amdgcn_mbcnt_lo(~0u, 0u)) & 32u) != 0u;
        return __builtin_bit_cast(float, up ? (unsigned)rr[0] : (unsigned)rr[1]);
    } else {
        return __builtin_bit_cast(float, __builtin_amdgcn_ds_swizzle(__builtin_bit_cast(int, v), (MASK << 10) | 0x1f));
    }
}
__device__ __forceinline__ float wave_sum(float v) {
    v += xshfl<1>(v); v += xshfl<2>(v); v += xshfl<4>(v); v += xshfl<8>(v); v += xshfl<16>(v); v += xshfl<32>(v);
    return v;
}
#define MFMA32(a, b, c) __builtin_amdgcn_mfma_f32_32x32x16_bf16((a), (b), (c), 0, 0, 0)
#define MFMA16(a, b, c) __builtin_amdgcn_mfma_f32_16x16x32_bf16((a), (b), (c), 0, 0, 0)

namespace pg8 {
constexpr int BM = 256, BK = 64, HALF = 128, HTB = HALF * BK * 2, STAGE_BYTES = 8 * HTB, NXCD = 8, WGM = 8;
__device__ __forceinline__ int lds_byte(int r, int c) { const int st = (r >> 4) * 2 + (c >> 5), rr = r & 15, cc = c & 31, ob = rr * 64 + cc * 2; return st * 1024 + (ob ^ (((ob >> 9) & 1) << 5)); }
__device__ __forceinline__ void stage_rc(int b, int& R, int& C) { const int st = b / 1024, sb = b % 1024, swz = sb ^ (((sb >> 9) & 1) << 5); R = (st >> 1) * 16 + swz / 64; C = (st & 1) * 32 + (swz % 64) / 2; }
__device__ __forceinline__ int perm32(int rho) { const int n = rho >> 4, i = rho & 15; return 8 * (i >> 2) + 4 * n + (i & 3); }

struct Unit { int pm, pn, prob; const char* a; const char* b; };
struct Sched {
    const char *A0, *A1, *B0, *B1; int nM0, nM1, nN0, nN1; int np, K, G, c;
    __device__ __forceinline__ int lda() const { return K; }
    __device__ __forceinline__ int ldb() const { return K; }
    __device__ __forceinline__ bool next(int i, Unit& u) const {
        long L = (long)i * G + c; int p = 0;
        const int n0 = nM0 * nN0;
        if (L >= n0) { if (np < 2) return false; L -= n0; p = 1; if (L >= nM1 * nN1) return false; }
        const int nm = p ? nM1 : nM0, nn = p ? nN1 : nN0, nwg = nm * nn;
        int wgid = (int)L; { const int q = nwg / NXCD, r = nwg % NXCD, xcd = wgid % NXCD, off = wgid / NXCD; wgid = (xcd < r ? xcd * (q + 1) : r * (q + 1) + (xcd - r) * q) + off; }
        const int nig = WGM * nn, gid = wgid / nig, fm = gid * WGM, gsz = (nm - fm) < WGM ? (nm - fm) : WGM;
        u.pm = fm + ((wgid % nig) % gsz); u.pn = (wgid % nig) / gsz; u.prob = p;
        const size_t tstep = (size_t)BM * K * 2;
        u.a = (p ? A1 : A0) + (size_t)u.pm * tstep; u.b = (p ? B1 : B0) + (size_t)u.pn * tstep; return true;
    }
};

struct SchedXA {
    const char* A; const char* B; int K, G, c;
    __device__ __forceinline__ int lda() const { return 1024; }
    __device__ __forceinline__ int ldb() const { return 256; }
    __device__ __forceinline__ bool next(int i, Unit& u) const {
        const long L = (long)i * G + c; if (L >= 256) return false;
        const int v = (int)L, xq = v & 7, off = v >> 3, pm = 8 * xq + (off & 7), head = off >> 3, b = pm >> 5, bh = b * 4 + head;
        u.pm = pm; u.pn = head; u.prob = 0;
        u.a = A + ((size_t)u.pm * 256 * 1024 + (size_t)head * 256) * 2; u.b = B + (size_t)bh * 256 * 256 * 2; return true;
    }
};
__device__ __forceinline__ int lane_id_asm_() { int l; asm volatile("v_mbcnt_lo_u32_b32 %0, -1, 0\n\tv_mbcnt_hi_u32_b32 %0, -1, %0" : "=v"(l)); return l; }
struct NoHook { __device__ __forceinline__ void operator()(int, f32x4 (&)[2][2][4][2], int, int) const {} };
struct HookMix {
    const LAS float* fac;
    __device__ __forceinline__ void operator()(int t, f32x4 (&acc)[2][2][4][2], int wr, int fr) const {
        if (t == 8 || t == 12) {
            const int idx = (t == 8) ? 0 : 1;
#pragma unroll
            for (int ai = 0; ai < 2; ++ai)
#pragma unroll
                for (int m = 0; m < 4; ++m) {
                    const float f = fac[(ai * 128 + wr * 64 + m * 16 + fr) * 4 + idx];
#pragma unroll
                    for (int bj = 0; bj < 2; ++bj)
#pragma unroll
                        for (int n = 0; n < 2; ++n) acc[ai][bj][m][n] *= f;
                }
        }
    }
};
template <class Epi, class SchedT, class HookT = NoHook>
__device__ __forceinline__ void gemm_phase(LAS unsigned char* lds, const SchedT& S, const Epi& E, int wave_, const HookT& H = HookT()) {
    const int tid_ = wave_ * 64 + lane_id_asm_();
    int K_ = S.K; asm volatile("" : "+s"(K_));
    const int tid = tid_, wid = __builtin_amdgcn_readfirstlane(tid >> 6), lane = tid & 63, wr = wid >> 2, wc = wid & 3, fr = lane & 15, fq = lane >> 4;
    const int K = K_, nt = K / BK;
    unsigned voffA[2], voffB[2];
#pragma unroll
    for (int i = 0; i < 2; ++i) { int R, C; stage_rc(tid * 16 + i * 8192, R, C); const int Rb = (R & ~31) + perm32(R & 31);
        voffA[i] = (unsigned)(R * S.lda() + C) * 2u; voffB[i] = (unsigned)(Rb * S.ldb() + C) * 2u; }
    const size_t kstep = (size_t)(BK * 2);
    const size_t hstepA = (size_t)HALF * S.lda() * 2, hstepB = (size_t)HALF * S.ldb() * 2;
    const unsigned ldsw = (unsigned)wid * 1024u;
    const int aoff = lds_byte(wr * 64 + fr, fq * 8), boff = lds_byte(wc * 32 + fr, fq * 8);
#define PG8_SA(b, h) (((b) * 2 + (h)) * HTB)
#define PG8_SB(b, h) ((4 + (b) * 2 + (h)) * HTB)
#define PG8_STAGE(bufoff, gbase, voff) do { _Pragma("unroll") for (int _i = 0; _i < 2; ++_i) \
        __builtin_amdgcn_global_load_lds((const unsigned*)((const char*)(gbase) + (voff)[_i]), (LAS unsigned*)(lds + (bufoff) + ldsw + _i * 8192), 16, 0, 0); } while (0)
#define PG8_LDA(dst, b, h) do { _Pragma("unroll") for (int m = 0; m < 4; ++m) _Pragma("unroll") for (int k = 0; k < 2; ++k) dst[m][k] = *(const LAS bf16x8*)(lds + PG8_SA(b, h) + aoff + m * 2048 + k * 1024); } while (0)
#define PG8_LDB(dst, b, h) do { _Pragma("unroll") for (int n = 0; n < 2; ++n) _Pragma("unroll") for (int k = 0; k < 2; ++k) dst[n][k] = *(const LAS bf16x8*)(lds + PG8_SB(b, h) + boff + n * 2048 + k * 1024); } while (0)
#define PG8_MMA(ai, bj, At, Bt) do { __builtin_amdgcn_s_setprio(1); _Pragma("unroll") for (int m = 0; m < 4; ++m) _Pragma("unroll") for (int n = 0; n < 2; ++n) _Pragma("unroll") for (int k = 0; k < 2; ++k) \
        acc[ai][bj][m][n] = __builtin_amdgcn_mfma_f32_16x16x32_bf16(Bt[n][k], At[m][k], acc[ai][bj][m][n], 0, 0, 0); __builtin_amdgcn_s_setprio(0); } while (0)
#define PG8_WAIT_V(n) asm volatile("s_waitcnt vmcnt(" #n ")" ::: "memory")
#define PG8_WAIT_L(n) asm volatile("s_waitcnt lgkmcnt(" #n ")" ::: "memory")
#define PG8_BAR __builtin_amdgcn_s_barrier()
#define PG8_SCHED __builtin_amdgcn_sched_barrier(0)
    Unit cur, nxt; int ui = 0;
    if (!S.next(0, cur)) return;
    f32x4 acc[2][2][4][2];
#pragma unroll
    for (int a = 0; a < 2; ++a)
#pragma unroll
        for (int b = 0; b < 2; ++b)
#pragma unroll
            for (int m = 0; m < 4; ++m)
#pragma unroll
                for (int n = 0; n < 2; ++n) acc[a][b][m][n] = (f32x4){0.f, 0.f, 0.f, 0.f};
    bf16x8 At[4][2], B0[2][2], B1[2][2];
    const char* cA = cur.a; const char* cB = cur.b;
    PG8_STAGE(PG8_SB(0, 0), cB, voffB); PG8_STAGE(PG8_SB(0, 1), cB + hstepB, voffB); PG8_STAGE(PG8_SA(0, 0), cA, voffA); PG8_STAGE(PG8_SA(0, 1), cA + hstepA, voffA);
    if (wr == 1) PG8_BAR;
    PG8_WAIT_V(2); PG8_BAR;
    PG8_STAGE(PG8_SB(1, 0), cB + kstep, voffB); PG8_STAGE(PG8_SA(1, 0), cA + kstep, voffA); PG8_STAGE(PG8_SB(1, 1), cB + hstepB + kstep, voffB);
    PG8_WAIT_V(6); PG8_BAR;
    for (;;) {
        const bool has_next = S.next(ui + 1, nxt);
        const char* nA = has_next ? nxt.a : cA; const char* nB = has_next ? nxt.b : cB;
        for (int t = 0; t < nt; t += 2) {
            H(t, acc, wr, fr);
            const bool last = (t == nt - 2);
            const char* a1 = cA + (size_t)(t + 1) * kstep;
            const char* a2 = last ? nA : cA + (size_t)(t + 2) * kstep; const char* b2 = last ? nB : cB + (size_t)(t + 2) * kstep;
            const char* a3 = a2 + kstep; const char* b3 = b2 + kstep;
            PG8_LDB(B0, 0, 0); PG8_LDB(B1, 0, 1); PG8_SCHED; PG8_LDA(At, 0, 0); PG8_STAGE(PG8_SA(1, 1), a1 + hstepA, voffA);
            PG8_WAIT_V(8); PG8_WAIT_L(0); PG8_BAR; PG8_MMA(0, 0, At, B0); PG8_MMA(0, 1, At, B1); PG8_BAR; PG8_SCHED;
            PG8_LDA(At, 0, 1); PG8_STAGE(PG8_SB(0, 0), b2, voffB); PG8_STAGE(PG8_SB(0, 1), b2 + hstepB, voffB); PG8_STAGE(PG8_SA(0, 0), a2, voffA);
            PG8_WAIT_V(8); PG8_WAIT_L(0); PG8_BAR; PG8_MMA(1, 0, At, B0); PG8_MMA(1, 1, At, B1); PG8_BAR; PG8_SCHED;
            PG8_LDB(B0, 1, 0); PG8_LDB(B1, 1, 1); PG8_SCHED; PG8_LDA(At, 1, 0); PG8_STAGE(PG8_SA(0, 1), a2 + hstepA, voffA);
            PG8_WAIT_V(8); PG8_WAIT_L(0); PG8_BAR; PG8_MMA(0, 0, At, B0); PG8_MMA(0, 1, At, B1); PG8_BAR; PG8_SCHED;
            PG8_LDA(At, 1, 1); PG8_STAGE(PG8_SB(1, 0), b3, voffB); PG8_STAGE(PG8_SB(1, 1), b3 + hstepB, voffB); PG8_STAGE(PG8_SA(1, 0), a3, voffA);
            PG8_WAIT_V(8); PG8_WAIT_L(0); PG8_BAR; PG8_MMA(1, 0, At, B0); PG8_MMA(1, 1, At, B1); PG8_BAR; PG8_SCHED;
        }
        if (wr == 0) PG8_BAR;
        E(acc, cur, wr, wc, fr, fq);
        if (!has_next) break;
#pragma unroll
        for (int a = 0; a < 2; ++a)
#pragma unroll
            for (int b = 0; b < 2; ++b)
#pragma unroll
                for (int m = 0; m < 4; ++m)
#pragma unroll
                    for (int n = 0; n < 2; ++n) acc[a][b][m][n] = (f32x4){0.f, 0.f, 0.f, 0.f};
        cur = nxt; cA = nA; cB = nB; ++ui;
        if (wr == 1) PG8_BAR;
    }
    PG8_WAIT_V(0);
    PG8_BAR;
#undef PG8_SA
#undef PG8_SB
#undef PG8_STAGE
#undef PG8_LDA
#undef PG8_LDB
#undef PG8_MMA
#undef PG8_WAIT_V
#undef PG8_WAIT_L
#undef PG8_BAR
#undef PG8_SCHED
}
}
using pg8::Unit;
#define GASP __attribute__((address_space(1)))
__device__ __forceinline__ unsigned char* launder(unsigned char* p) { unsigned long long v = (unsigned long long)p; asm volatile("" : "+s"(v)); return (unsigned char*)(GASP unsigned char*)v; }
__device__ __forceinline__ int lane_id_asm() { int l; asm volatile("v_mbcnt_lo_u32_b32 %0, -1, 0\n\tv_mbcnt_hi_u32_b32 %0, -1, %0" : "=v"(l)); return l; }
__device__ __forceinline__ int launder_i(int v) { asm volatile("" : "+s"(v)); return v; }
#define SSP(l, k) ((float*)(ws + WS_SS) + (size_t)((l) * 6 + (k)) * M)
typedef f32x4 Acc[2][2][4][2];

__device__ __forceinline__ void st16(bf16_t* p, const float* v) {
    u32x4 w; w.x = cvt_pk_bf16(v[0], v[1]); w.y = cvt_pk_bf16(v[2], v[3]); w.z = cvt_pk_bf16(v[4], v[5]); w.w = cvt_pk_bf16(v[6], v[7]);
    *(u32x4*)p = w;
}

__device__ __forceinline__ void load_rs(float (&rs)[2][4], const float* ssx, int row0) {
#pragma unroll
    for (int ai = 0; ai < 2; ++ai)
#pragma unroll
        for (int m = 0; m < 4; ++m) rs[ai][m] = ssx[row0 + ai * 128 + m * 16];
#pragma unroll
    for (int ai = 0; ai < 2; ++ai)
#pragma unroll
        for (int m = 0; m < 4; ++m) rs[ai][m] = __builtin_amdgcn_rsqf(rs[ai][m] * (1.f / 1024.f) + EPS);
}
__device__ __forceinline__ void st16_nt(bf16_t* p, const float* v) {
    u32x4 w; w.x = cvt_pk_bf16(v[0], v[1]); w.y = cvt_pk_bf16(v[2], v[3]); w.z = cvt_pk_bf16(v[4], v[5]); w.w = cvt_pk_bf16(v[6], v[7]);
    __builtin_nontemporal_store(w, (u32x4*)p);
}
struct EpiIn {
    unsigned char* ws_; int l; const float* qg; const float* kg;
    __device__ __forceinline__ void operator()(const Acc& acc, const Unit& u, int wr, int wc, int fr, int fq) const {
        unsigned char* ws = launder(ws_);
        const float* ssx = SSP(l, SS_MIX);
        bf16_t* Q = (bf16_t*)(ws + WS_Q); bf16_t* Kb = (bf16_t*)(ws + WS_K); bf16_t* Vt = (bf16_t*)(ws + WS_VT); bf16_t* HC = (bf16_t*)(ws + WS_HC); bf16_t* U = (bf16_t*)(ws + WS_U);
        float* kraw = (float*)(ws + WS_KRAW); bf16_t* vtm = (bf16_t*)(ws + WS_VTM);
        if (u.prob == 0) {
            const int pn = u.pn;
            float rsv[2][4]; load_rs(rsv, ssx, u.pm * 256 + wr * 64 + fr);
            if (pn < 4) {
                const float* g = (pn < 2) ? qg : kg; bf16_t* dst = (pn < 2) ? Q : Kb;
                const float post = (pn < 2) ? 0.125f * LOG2E : 1.0f;
                const int head = 4 * (pn & 1) + wc;
#pragma unroll
                for (int ai = 0; ai < 2; ++ai)
#pragma unroll
                    for (int m = 0; m < 4; ++m) {
                        const int row = u.pm * 256 + ai * 128 + wr * 64 + m * 16 + fr;
                        const float rs = rsv[ai][m];
                        f32x4 v[2][2]; float ss = 0.f;
#pragma unroll
                        for (int bj = 0; bj < 2; ++bj)
#pragma unroll
                            for (int n = 0; n < 2; ++n) { v[bj][n] = acc[ai][bj][m][n] * rs; const f32x4 x = v[bj][n]; ss += (x[0] * x[0] + x[1] * x[1]) + (x[2] * x[2] + x[3] * x[3]); }
                        ss += xshfl<16>(ss); ss += xshfl<32>(ss);
                        const float hn = __builtin_amdgcn_rsqf(ss * (1.f / 64.f) + EPS) * post;
#pragma unroll
                        for (int bj = 0; bj < 2; ++bj) {
                            float o[8];
#pragma unroll
                            for (int n = 0; n < 2; ++n) { const f32x4 gv = *(const f32x4*)(g + 32 * bj + 8 * fq + 4 * n);
#pragma unroll
                                for (int j = 0; j < 4; ++j) o[4 * n + j] = v[bj][n][j] * hn * gv[j]; }
                            st16(dst + (size_t)row * 512 + head * 64 + 32 * bj + 8 * fq, o);
                        }
                        asm volatile("" ::: "memory");
                    }
            } else if (pn < 6) {
#pragma unroll
                for (int ai = 0; ai < 2; ++ai)
#pragma unroll
                    for (int m = 0; m < 4; ++m) {
                        const int row = u.pm * 256 + ai * 128 + wr * 64 + m * 16 + fr;
                        const float rs = rsv[ai][m];
                        const int b = row >> 13, t = row & (SEQ - 1);
#pragma unroll
                        for (int bj = 0; bj < 2; ++bj) {
                            const int h = 4 * (pn - 4) + 2 * bj + (wc >> 1);
#pragma unroll
                            for (int n = 0; n < 2; ++n)
#pragma unroll
                                for (int j = 0; j < 4; ++j) {
                                    const int d = 32 * (wc & 1) + 8 * fq + 4 * n + j;
                                    Vt[((size_t)(b * 8 + h) * 64 + d) * SEQ + t] = f2bf(acc[ai][bj][m][n][j] * rs);
                                }
                        }
                    }
            } else if (pn < 8) {
#pragma unroll
                for (int ai = 0; ai < 2; ++ai)
#pragma unroll
                    for (int m = 0; m < 4; ++m) {
                        const int row = u.pm * 256 + ai * 128 + wr * 64 + m * 16 + fr;
                        const float rs = rsv[ai][m];
                        float o[8];
#pragma unroll
                        for (int n = 0; n < 2; ++n)
#pragma unroll
                            for (int j = 0; j < 4; ++j) { const float a = acc[ai][0][m][n][j] * rs, b = acc[ai][1][m][n][j] * rs; o[4 * n + j] = a * sigmoidf_(b); }
                        st16(HC + (size_t)row * 256 + 128 * (pn - 6) + 32 * wc + 8 * fq, o);
                    }
            } else {
#pragma unroll
                for (int ai = 0; ai < 2; ++ai)
#pragma unroll
                    for (int m = 0; m < 4; ++m) {
                        const int row = u.pm * 256 + ai * 128 + wr * 64 + m * 16 + fr;
                        const float rs = rsv[ai][m];
#pragma unroll
                        for (int bj = 0; bj < 2; ++bj) {
                            float o[8];
#pragma unroll
                            for (int n = 0; n < 2; ++n)
#pragma unroll
                                for (int j = 0; j < 4; ++j) o[4 * n + j] = acc[ai][bj][m][n][j] * rs;
                            st16(U + (size_t)row * 256 + 128 * bj + 32 * wc + 8 * fq, o);
                        }
                    }
            }
        } else {
            const int lay = u.pn >> 3, sub = u.pn & 7;
#pragma unroll
            for (int ai = 0; ai < 2; ++ai)
#pragma unroll
                for (int m = 0; m < 4; ++m) {
                    const int row = u.pm * 256 + ai * 128 + wr * 64 + m * 16 + fr;
                    if (sub < 4) {
#pragma unroll
                        for (int bj = 0; bj < 2; ++bj)
#pragma unroll
                            for (int n = 0; n < 2; ++n)
                                *(f32x4*)(kraw + ((size_t)lay * 512 + row) * 1024 + sub * 256 + 128 * bj + 32 * wc + 8 * fq + 4 * n) = acc[ai][bj][m][n];
                    } else {
                        const int b = row >> 8, mt = row & 255, head = sub - 4;
#pragma unroll
                        for (int bj = 0; bj < 2; ++bj)
#pragma unroll
                            for (int n = 0; n < 2; ++n)
#pragma unroll
                                for (int j = 0; j < 4; ++j) {
                                    const int d = 128 * bj + 32 * wc + 8 * fq + 4 * n + j;
                                    vtm[((size_t)((lay * 2 + b) * 4 + head) * 256 + d) * 256 + mt] = f2bf(acc[ai][bj][m][n][j]);
                                }
                    }
                }
        }
    }
};

struct EpiPwGlu {
    unsigned char* ws_; int l;
    __device__ __forceinline__ void operator()(const Acc& acc, const Unit& u, int wr, int wc, int fr, int fq) const {
        unsigned char* ws = launder(ws_);
        bf16_t* MIX = (bf16_t*)(ws + WS_MIX); float* ss_conv = SSP(l, SS_CONV);
#pragma unroll
        for (int ai = 0; ai < 2; ++ai)
#pragma unroll
            for (int m = 0; m < 4; ++m) {
                const int row = u.pm * 256 + ai * 128 + wr * 64 + m * 16 + fr;
                float ss = 0.f;
                if (u.prob == 0) {
#pragma unroll
                    for (int bj = 0; bj < 2; ++bj) {
                        float o[8];
#pragma unroll
                        for (int n = 0; n < 2; ++n)
#pragma unroll
                            for (int j = 0; j < 4; ++j) { o[4 * n + j] = acc[ai][bj][m][n][j]; ss += o[4 * n + j] * o[4 * n + j]; }
                        st16(MIX + (size_t)row * 1024 + 512 + 128 * bj + 32 * wc + 8 * fq, o);
                    }
                } else {
                    float o[8];
#pragma unroll
                    for (int n = 0; n < 2; ++n)
#pragma unroll
                        for (int j = 0; j < 4; ++j) { const float v = acc[ai][0][m][n][j] * sigmoidf_(acc[ai][1][m][n][j]); o[4 * n + j] = v; ss += v * v; }
                    st16(MIX + (size_t)row * 1024 + 768 + 128 * u.pn + 32 * wc + 8 * fq, o);
                }
                ss += xshfl<16>(ss); ss += xshfl<32>(ss);
                if (fq == 0) atomicAdd(ss_conv + (size_t)u.prob * M + row, ss);
            }
    }
};

struct EpiRes {
    float* xfinal; unsigned char* ws_; int ssidx;
    const LAS float* fac;
    __device__ __forceinline__ void operator()(const Acc& acc, const Unit& u, int wr, int wc, int fr, int fq) const {
        unsigned char* ws = launder(ws_);
        bf16_t* XB = (bf16_t*)(ws + WS_XB); float* ssn = ssidx >= 0 ? (float*)(ws + WS_SS) + (size_t)ssidx * M : nullptr;
#pragma unroll
        for (int ai = 0; ai < 2; ++ai) {
            u32x4 xh[4][2];
#pragma unroll
            for (int m = 0; m < 4; ++m) {
                const size_t off = (size_t)(u.pm * 256 + ai * 128 + wr * 64 + m * 16 + fr) * 1024 + u.pn * 256 + 32 * wc + 8 * fq;
#pragma unroll
                for (int bj = 0; bj < 2; ++bj) xh[m][bj] = *(const u32x4*)(XB + off + 128 * bj);
            }
#pragma unroll
            for (int m = 0; m < 4; ++m) {
                const int row = u.pm * 256 + ai * 128 + wr * 64 + m * 16 + fr;
                const float f3 = fac ? fac[(ai * 128 + wr * 64 + m * 16 + fr) * 4 + 2] : 1.f;
                float ss = 0.f;
#pragma unroll
                for (int bj = 0; bj < 2; ++bj) {
                    const size_t off = (size_t)row * 1024 + u.pn * 256 + 128 * bj + 32 * wc + 8 * fq;
                    float o[8];
#pragma unroll
                    for (int n = 0; n < 2; ++n)
#pragma unroll
                        for (int j = 0; j < 4; ++j) {
                            const int e = 4 * n + j; const unsigned wh = xh[m][bj][e >> 1];
                            const float v = ((e & 1) ? bfhi(wh) : bflo(wh)) + acc[ai][bj][m][n][j] * f3;
                            o[e] = v; ss += v * v;
                        }
                    if (xfinal) { *(f32x4*)(xfinal + off) = (f32x4){o[0], o[1], o[2], o[3]}; *(f32x4*)(xfinal + off + 4) = (f32x4){o[4], o[5], o[6], o[7]}; }
                    else st16(XB + off, o);
                }
                if (ssn) { ss += xshfl<16>(ss); ss += xshfl<32>(ss); if (fq == 0) atomicAdd(ssn + row, ss); }
            }
            asm volatile("" ::: "memory");
        }
    }
};

struct EpiQ {
    unsigned char* ws_; int l;
    __device__ __forceinline__ void operator()(const Acc& acc, const Unit& u, int wr, int wc, int fr, int fq) const {
        unsigned char* ws = launder(ws_);
        const float* ssx = SSP(l, SS_XA); bf16_t* XQ = (bf16_t*)(ws + WS_MIX);
        float rsv[2][4]; load_rs(rsv, ssx, u.pm * 256 + wr * 64 + fr);
#pragma unroll
        for (int ai = 0; ai < 2; ++ai)
#pragma unroll
            for (int m = 0; m < 4; ++m) {
                const int row = u.pm * 256 + ai * 128 + wr * 64 + m * 16 + fr;
                const float rs = rsv[ai][m];
                float ss = 0.f;
#pragma unroll
                for (int bj = 0; bj < 2; ++bj) {
                    float o[8];
#pragma unroll
                    for (int n = 0; n < 2; ++n)
#pragma unroll
                        for (int j = 0; j < 4; ++j) { o[4 * n + j] = acc[ai][bj][m][n][j] * rs; ss += o[4 * n + j] * o[4 * n + j]; }
                    st16(XQ + (size_t)row * 1024 + u.pn * 256 + 128 * bj + 32 * wc + 8 * fq, o);
                }
                ss += xshfl<16>(ss); ss += xshfl<32>(ss);
                if (fq == 0) atomicAdd((float*)(ws + WS_SSQ) + (size_t)(l * 4 + u.pn) * M + row, ss);
                asm volatile("" ::: "memory");
            }
    }
};

struct EpiFfn {
    unsigned char* ws_; int l;
    __device__ __forceinline__ void operator()(const Acc& acc, const Unit& u, int wr, int wc, int fr, int fq) const {
        unsigned char* ws = launder(ws_);
        const float* ssx = SSP(l, SS_FFN); bf16_t* HF = (bf16_t*)(ws + WS_HF);
        float rsv[2][4]; load_rs(rsv, ssx, u.pm * 256 + wr * 64 + fr);
#pragma unroll
        for (int ai = 0; ai < 2; ++ai)
#pragma unroll
            for (int m = 0; m < 4; ++m) {
                const int row = u.pm * 256 + ai * 128 + wr * 64 + m * 16 + fr;
                const float rs = rsv[ai][m];
                float o[8];
#pragma unroll
                for (int n = 0; n < 2; ++n)
#pragma unroll
                    for (int j = 0; j < 4; ++j) { const float g = acc[ai][0][m][n][j] * rs, up = acc[ai][1][m][n][j] * rs; o[4 * n + j] = g * sigmoidf_(g) * up; }
                st16_nt(HF + (size_t)row * FFH + 128 * u.pn + 32 * wc + 8 * fq, o);
            }
    }
};

constexpr int EX_OFF = 131072 + 4096;
struct EpiSm {
    unsigned char* ws_; int l; LAS unsigned char* lds;
    __device__ __forceinline__ void operator()(const Acc& acc, const Unit& u, int wr, int wc, int fr, int fq) const {
        unsigned char* ws = launder(ws_);
        const float* ssq = (const float*)(ws + WS_SSQ) + (size_t)(l * 4 + u.pn) * M;
        bf16_t* P = (bf16_t*)(ws + WS_HF);
        LAS float* EXm = (LAS float*)(lds + EX_OFF); LAS float* EXs = EXm + 1024;
        float rq[2][4], mx[2][4];
#pragma unroll
        for (int ai = 0; ai < 2; ++ai)
#pragma unroll
            for (int m = 0; m < 4; ++m) {
                const int rl = ai * 128 + wr * 64 + m * 16 + fr;
                rq[ai][m] = __builtin_amdgcn_rsqf(ssq[u.pm * 256 + rl] * (1.f / 256.f) + EPS) * (0.0625f * LOG2E);
                float v = -3.0e38f;
#pragma unroll
                for (int bj = 0; bj < 2; ++bj)
#pragma unroll
                    for (int n = 0; n < 2; ++n)
#pragma unroll
                        for (int j = 0; j < 4; ++j) v = fmaxf(v, acc[ai][bj][m][n][j]);
                v *= rq[ai][m];
                v = fmaxf(v, xshfl<16>(v)); v = fmaxf(v, xshfl<32>(v));
                if (fq == 0) EXm[rl * 4 + wc] = v;
            }
        asm volatile("s_waitcnt lgkmcnt(0)" ::: "memory"); __builtin_amdgcn_s_barrier(); asm volatile("" ::: "memory");
#pragma unroll
        for (int ai = 0; ai < 2; ++ai)
#pragma unroll
            for (int m = 0; m < 4; ++m) {
                const int rl = ai * 128 + wr * 64 + m * 16 + fr;
                const f32x4 e = *(const LAS f32x4*)(EXm + rl * 4);
                mx[ai][m] = fmaxf(fmaxf(e[0], e[1]), fmaxf(e[2], e[3]));
                float s = 0.f;
#pragma unroll
                for (int bj = 0; bj < 2; ++bj)
#pragma unroll
                    for (int n = 0; n < 2; ++n)
#pragma unroll
                        for (int j = 0; j < 4; ++j) s += ex2(acc[ai][bj][m][n][j] * rq[ai][m] - mx[ai][m]);
                s += xshfl<16>(s); s += xshfl<32>(s);
                if (fq == 0) EXs[rl * 4 + wc] = s;
            }
        asm volatile("s_waitcnt lgkmcnt(0)" ::: "memory"); __builtin_amdgcn_s_barrier(); asm volatile("" ::: "memory");
#pragma unroll
        for (int ai = 0; ai < 2; ++ai)
#pragma unroll
            for (int m = 0; m < 4; ++m) {
                const int rl = ai * 128 + wr * 64 + m * 16 + fr;
                const f32x4 e = *(const LAS f32x4*)(EXs + rl * 4);
                const float inv = __builtin_amdgcn_rcpf((e[0] + e[1]) + (e[2] + e[3]));
#pragma unroll
                for (int bj = 0; bj < 2; ++bj) {
                    float o[8];
#pragma unroll
                    for (int n = 0; n < 2; ++n)
#pragma unroll
                        for (int j = 0; j < 4; ++j) o[4 * n + j] = ex2(acc[ai][bj][m][n][j] * rq[ai][m] - mx[ai][m]) * inv;
                    st16(P + (size_t)(u.pm * 256 + rl) * 1024 + u.pn * 256 + 128 * bj + 32 * wc + 8 * fq, o);
                }
            }
    }
};
struct EpiPlain {
    unsigned char* ws_; size_t off;
    __device__ __forceinline__ void operator()(const Acc& acc, const Unit& u, int wr, int wc, int fr, int fq) const {
        bf16_t* O = (bf16_t*)(launder(ws_) + off);
#pragma unroll
        for (int ai = 0; ai < 2; ++ai)
#pragma unroll
            for (int m = 0; m < 4; ++m) {
                const int row = u.pm * 256 + ai * 128 + wr * 64 + m * 16 + fr;
#pragma unroll
                for (int bj = 0; bj < 2; ++bj) {
                    float o[8];
#pragma unroll
                    for (int n = 0; n < 2; ++n)
#pragma unroll
                        for (int j = 0; j < 4; ++j) o[4 * n + j] = acc[ai][bj][m][n][j];
                    st16(O + (size_t)row * 1024 + u.pn * 256 + 128 * bj + 32 * wc + 8 * fq, o);
                }
            }
    }
};

constexpr int XBST_OFF = 131072 + 512;
constexpr int ARGS_OFF = 131072 + 1024;
__device__ __forceinline__ unsigned char* argp(LAS unsigned char* lds, int i) {
    unsigned addr = (unsigned)(uintptr_t)(lds + ARGS_OFF) + 8u * (unsigned)i; asm volatile("" : "+s"(addr));
    const unsigned long long v = *(volatile LAS unsigned long long*)(uintptr_t)addr;
    const unsigned lo = __builtin_amdgcn_readfirstlane((unsigned)v), hi = __builtin_amdgcn_readfirstlane((unsigned)(v >> 32));
    return (unsigned char*)(GASP unsigned char*)(((unsigned long long)hi << 32) | lo);
}
#define AIN(k) ((const float*)argp(lds, (k)))
#define AOUT() ((float*)argp(lds, 33))

__device__ __forceinline__ void transpose_item(const float* W, int K, int Nsrc, bf16_t* WT, int dst_row0, int src_col0, int k0, const float* gain, LAS float* scr, int lane) {
    float wv[32];
#pragma unroll
    for (int i = 0; i < 32; ++i) wv[i] = W[(size_t)(k0 + 2 * i + (lane >> 5)) * Nsrc + src_col0 + (lane & 31)];
    if (gain) {
#pragma unroll
        for (int i = 0; i < 32; ++i) wv[i] *= gain[k0 + 2 * i + (lane >> 5)];
    }
#pragma unroll
    for (int i = 0; i < 32; ++i) scr[(2 * i + (lane >> 5)) * 33 + (lane & 31)] = wv[i];
    asm volatile("s_waitcnt lgkmcnt(0)" ::: "memory");
    const int c = lane & 7;
#pragma unroll
    for (int j = 0; j < 4; ++j) { const int n = (lane >> 3) + 8 * j; const LAS float* s = scr + (8 * c) * 33 + n;
        u32x4 o; o.x = cvt_pk_bf16(s[0 * 33], s[1 * 33]); o.y = cvt_pk_bf16(s[2 * 33], s[3 * 33]); o.z = cvt_pk_bf16(s[4 * 33], s[5 * 33]); o.w = cvt_pk_bf16(s[6 * 33], s[7 * 33]);
        *(u32x4*)(WT + (size_t)(dst_row0 + n) * K + k0 + 8 * c) = o; }
    asm volatile("s_waitcnt lgkmcnt(0)" ::: "memory");
}
__device__ __forceinline__ int colmap_in(int c) { const int pn = c >> 8, bj = (c >> 7) & 1, wc = (c >> 5) & 3;
    if (pn < 4) return 256 * pn + 64 * wc + 32 * bj;
    if (pn == 6 || pn == 7) return 1536 + 256 * bj + 128 * (pn - 6) + 32 * wc;
    return c; }
__device__ __forceinline__ int colmap_ffn(int c) { const int pn = c >> 8, bj = (c >> 7) & 1, wc = (c >> 5) & 3; return FFH * bj + 128 * pn + 32 * wc; }
__device__ __forceinline__ int colmap_glu(int c) { const int pn = c >> 8, bj = (c >> 7) & 1, wc = (c >> 5) & 3; return 256 * bj + 128 * pn + 32 * wc; }

struct KArgs { const float* in[33]; float* out; unsigned char* ws; };

__device__ __forceinline__ void transpose_job(int it, const float* W, int K, int Nsrc, int Ndst, bf16_t* WT, int dst_row_off, const float* gain, int mode, LAS float* scr, int lane) {
    const int nblk = Ndst / 32, kb = it / nblk, nb = it % nblk, n0 = 32 * nb;
    const int src = mode == 1 ? colmap_in(n0) : mode == 2 ? colmap_ffn(n0) : mode == 3 ? colmap_glu(n0) : n0;
    transpose_item(W, K, Nsrc, WT, dst_row_off + n0, src, 64 * kb, gain, scr, lane);
}

constexpr int CI_IN = (DM / 64) * (NIN / 32), CI_SQ = (DM / 64) * (DM / 32), CI_FFI = (DM / 64) * (2 * FFH / 32), CI_FFO = (FFH / 64) * (DM / 32), CI_PW2 = (256 / 64) * (256 / 32), CI_GLU = (256 / 64) * (512 / 32);
constexpr int CI_KV0 = CI_IN + 3 * CI_SQ, CI_KV1 = CI_IN + 5 * CI_SQ;
constexpr int CI_NIT = CI_IN + 5 * CI_SQ + CI_FFI + CI_FFO + CI_PW2 + CI_GLU, CI_DEFER = CI_NIT - 2 * CI_SQ;
__device__ __forceinline__ void convert_item(LAS unsigned char* lds, unsigned char* ws, int l, int it, LAS float* scr, int lane) {
    unsigned char* wl = ws + WS_W + (size_t)l * WL_STRIDE;
    int r = it;
    if (r < CI_IN) { transpose_job(r, AIN(3) + (size_t)l * DM * NIN, DM, NIN, NIN, (bf16_t*)(wl + WL_IN), 0, AIN(2) + l * DM, 1, scr, lane); return; } r -= CI_IN;
    if (r < CI_SQ) { transpose_job(r, AIN(21) + (size_t)l * DM * DM, DM, DM, DM, (bf16_t*)(wl + WL_OUT), 0, AIN(20) + l * DM, 0, scr, lane); return; } r -= CI_SQ;
    if (r < CI_SQ) { transpose_job(r, AIN(24) + (size_t)l * DM * DM, DM, DM, DM, (bf16_t*)(wl + WL_Q), 0, AIN(22) + l * DM, 0, scr, lane); return; } r -= CI_SQ;
    if (r < CI_SQ) { transpose_job(r, AIN(29) + (size_t)l * DM * DM, DM, DM, DM, (bf16_t*)(wl + WL_O), 0, nullptr, 0, scr, lane); return; } r -= CI_SQ;
    if (r < CI_SQ) { transpose_job(r, AIN(25) + (size_t)l * DM * DM, DM, DM, DM, (bf16_t*)(ws + WS_WKV) + (size_t)l * 2048 * 1024, 0, AIN(23) + l * DM, 0, scr, lane); return; } r -= CI_SQ;
    if (r < CI_SQ) { transpose_job(r, AIN(26) + (size_t)l * DM * DM, DM, DM, DM, (bf16_t*)(ws + WS_WKV) + (size_t)l * 2048 * 1024, 1024, AIN(23) + l * DM, 0, scr, lane); return; } r -= CI_SQ;
    if (r < CI_FFI) { transpose_job(r, AIN(31) + (size_t)l * DM * 2 * FFH, DM, 2 * FFH, 2 * FFH, (bf16_t*)(wl + WL_FFI), 0, AIN(30) + l * DM, 2, scr, lane); return; } r -= CI_FFI;
    if (r < CI_FFO) { transpose_job(r, AIN(32) + (size_t)l * FFH * DM, FFH, DM, DM, (bf16_t*)(wl + WL_FFO), 0, nullptr, 0, scr, lane); return; } r -= CI_FFO;
    if (r < CI_PW2) { transpose_job(r, AIN(10) + (size_t)l * 256 * 256, 256, 256, 256, (bf16_t*)(wl + WL_PW2), 0, nullptr, 0, scr, lane); return; } r -= CI_PW2;
    transpose_job(r, AIN(19) + (size_t)l * 256 * 512, 256, 512, 512, (bf16_t*)(wl + WL_GLU), 0, nullptr, 3, scr, lane);
}
constexpr int CI_D0 = CI_FFI + CI_FFO, CI_DTOT = CI_D0 + CI_DEFER, CI_DSPLIT = CI_D0 + 3000;
__device__ __forceinline__ void convert_deferred(LAS unsigned char* lds, unsigned char* ws, int d, LAS float* scr, int lane) {
    if (d < CI_D0) convert_item(lds, ws, 0, CI_KV1 + d, scr, lane);
    else { const int it = d - CI_D0; convert_item(lds, ws, 1, it < CI_KV0 ? it : it + 2 * CI_SQ, scr, lane); }
}
__device__ __forceinline__ void prologue(const KArgs& a, LAS unsigned char* lds, int gw, int NGW, int wave, int lane) {
    unsigned char* ws = a.ws;
    LAS float* scr = (LAS float*)(lds + wave * 16384);
    { float* ss = (float*)(ws + WS_SS); for (int i = gw * 64 + lane; i < 11 * M; i += NGW * 64) ss[M + i] = 0.f; }
    { float* sq = (float*)(ws + WS_SSQ); for (int i = gw * 64 + lane; i < 8 * M; i += NGW * 64) sq[i] = 0.f; }
    for (int it = gw; it < (CI_NIT - CI_D0) + 2 * CI_SQ; it += NGW) {
        if (it < CI_KV1) convert_item(lds, ws, 0, it, scr, lane);
        else if (it < CI_NIT - CI_D0) convert_item(lds, ws, 0, it + CI_D0, scr, lane);
        else convert_item(lds, ws, 1, CI_KV0 + (it - (CI_NIT - CI_D0)), scr, lane);
    }
    for (int r = gw; r < M + BATCH * NMEM; r += NGW) {
        const bool isx = r < M;
        const float* src = isx ? a.in[0] + (size_t)r * DM : a.in[1] + (size_t)(r - M) * DM;
        f32x4 v[4]; float s = 0.f;
#pragma unroll
        for (int j = 0; j < 4; ++j) { v[j] = *(const f32x4*)(src + 256 * j + 4 * lane); s += (v[j].x * v[j].x + v[j].y * v[j].y) + (v[j].z * v[j].z + v[j].w * v[j].w); }
        s = wave_sum(s);
        float sc = 1.f; bf16_t* dst;
        if (isx) { if (lane == 0) ((float*)(ws + WS_SS))[r] = s; dst = (bf16_t*)(ws + WS_XB) + (size_t)r * DM; }
        else { sc = __builtin_amdgcn_rsqf(s * (1.f / 1024.f) + EPS); dst = (bf16_t*)(ws + WS_HMN) + (size_t)(r - M) * DM; }
#pragma unroll
        for (int j = 0; j < 4; ++j) { u32x2 w; w.x = cvt_pk_bf16(v[j].x * sc, v[j].y * sc); w.y = cvt_pk_bf16(v[j].z * sc, v[j].w * sc); *(u32x2*)(dst + 256 * j + 4 * lane) = w; }
    }
}

__device__ __forceinline__ void sb_task(int task, const bf16_t* Q, const bf16_t* Kb, const bf16_t* Vt, bf16_t* MIX, float* ss_sb, int lane, bool do_atomic = true) {
    const int r32 = lane & 31, hi = lane >> 5;
    const int qb = task & 255, h = (task >> 8) & 7, b = task >> 11;
    const size_t rowbase = (size_t)b * SEQ; const int q0 = qb * 32;
    bf16x8 qf[4];
    { const bf16_t* qp = Q + (rowbase + q0 + r32) * 512 + h * 64 + hi * 8;
#pragma unroll
      for (int ks = 0; ks < 4; ++ks) qf[ks] = *(const bf16x8*)(qp + ks * 16); }
    f32x16 o0, o1;
#pragma unroll
    for (int r = 0; r < 16; ++r) { o0[r] = 0.f; o1[r] = 0.f; }
    float R = 0.f;
    const bf16_t* vt = Vt + (size_t)(b * 8 + h) * 64 * SEQ;
    for (int k0 = q0; k0 >= 0; k0 -= 32) {
        const bf16_t* kp = Kb + (rowbase + k0 + r32) * 512 + h * 64 + hi * 8;
        bf16x8 kf[4];
#pragma unroll
        for (int ks = 0; ks < 4; ++ks) kf[ks] = *(const bf16x8*)(kp + ks * 16);
        s16x4 vlo[2][2], vhi[2][2];
#pragma unroll
        for (int j = 0; j < 2; ++j)
#pragma unroll
            for (int db = 0; db < 2; ++db) { const bf16_t* vp = vt + (size_t)(32 * db + r32) * SEQ + k0 + 16 * j + 4 * hi; vlo[j][db] = *(const s16x4*)vp; vhi[j][db] = *(const s16x4*)(vp + 8); }
        f32x16 s;
#pragma unroll
        for (int r = 0; r < 16; ++r) s[r] = 0.f;
#pragma unroll
        for (int ks = 0; ks < 4; ++ks) s = MFMA32(kf[ks], qf[ks], s);
        const bool diag = (k0 == q0);
        float Lr[16];
#pragma unroll
        for (int r = 0; r < 16; ++r) {
            const float z = s[r];
            float Lv = fminf(-z, 0.f) - lg2(1.f + ex2(-fabsf(z)));
            if (diag && crow(r, hi) >= r32) Lv = 0.f;
            Lr[r] = Lv;
        }
        float tot[4], oth[4], pr[4];
#pragma unroll
        for (int G = 0; G < 4; ++G) { Lr[4 * G + 2] += Lr[4 * G + 3]; Lr[4 * G + 1] += Lr[4 * G + 2]; Lr[4 * G] += Lr[4 * G + 1]; tot[G] = Lr[4 * G]; }
#pragma unroll
        for (int G = 0; G < 4; ++G) { oth[G] = xshfl<32>(tot[G]); pr[G] = tot[G] + oth[G]; }
        float off[4];
        { const float sp3 = 0.f, sp2 = pr[3], sp1 = sp2 + pr[2], sp0 = sp1 + pr[1];
          off[3] = sp3 + R; off[2] = sp2 + R; off[1] = sp1 + R; off[0] = sp0 + R;
          if (hi == 0) { off[0] += oth[0]; off[1] += oth[1]; off[2] += oth[2]; off[3] += oth[3]; }
          R += sp0 + pr[0]; }
        float w[16];
#pragma unroll
        for (int r = 0; r < 16; ++r) { float wv = ex2(s[r] + Lr[r] + off[r >> 2]); if (diag && crow(r, hi) >= r32) wv = 0.f; w[r] = wv; }
        bf16x8 pa[2];
#pragma unroll
        for (int j = 0; j < 2; ++j) { u32x4 p; p.x = cvt_pk_bf16(w[8 * j], w[8 * j + 1]); p.y = cvt_pk_bf16(w[8 * j + 2], w[8 * j + 3]); p.z = cvt_pk_bf16(w[8 * j + 4], w[8 * j + 5]); p.w = cvt_pk_bf16(w[8 * j + 6], w[8 * j + 7]); pa[j] = __builtin_bit_cast(bf16x8, p); }
#pragma unroll
        for (int j = 0; j < 2; ++j) {
            const bf16x8 v0 = (bf16x8){vlo[j][0][0], vlo[j][0][1], vlo[j][0][2], vlo[j][0][3], vhi[j][0][0], vhi[j][0][1], vhi[j][0][2], vhi[j][0][3]};
            const bf16x8 v1 = (bf16x8){vlo[j][1][0], vlo[j][1][1], vlo[j][1][2], vlo[j][1][3], vhi[j][1][0], vhi[j][1][1], vhi[j][1][2], vhi[j][1][3]};
            o0 = MFMA32(pa[j], v0, o0); o1 = MFMA32(pa[j], v1, o1);
        }
        if (__all(R < -34.f)) break;
    }
#pragma unroll
    for (int r = 0; r < 16; ++r) {
        const size_t row = rowbase + q0 + crow(r, hi);
        MIX[row * 1024 + h * 64 + r32] = f2bf(o0[r]);
        MIX[row * 1024 + h * 64 + 32 + r32] = f2bf(o1[r]);
        float ss = o0[r] * o0[r] + o1[r] * o1[r];
        ss += xshfl<1>(ss); ss += xshfl<2>(ss); ss += xshfl<4>(ss); ss += xshfl<8>(ss); ss += xshfl<16>(ss);
        if (r32 == 0 && do_atomic) atomicAdd(ss_sb + row, ss);
    }
}

__device__ __forceinline__ void conv_task(int task, const bf16_t* HC, const LAS float* wlds, const float* dw_b, const float* ln_g, const float* ln_b, bf16_t* AC, int lane) {
    const int row0 = task * 4, t0 = row0 & (SEQ - 1);
    float acc[4][4];
    { const f32x4 bv = *(const f32x4*)(dw_b + 4 * lane);
#pragma unroll
      for (int tt = 0; tt < 4; ++tt) { acc[tt][0] = bv.x; acc[tt][1] = bv.y; acc[tt][2] = bv.z; acc[tt][3] = bv.w; } }
    u32x2 hv[34];
#pragma unroll
    for (int rr = 0; rr < 34; ++rr) {
        const int t = t0 - 30 + rr;
        u32x2 w = (u32x2){0u, 0u};
        if (t >= 0) w = *(const u32x2*)(HC + (size_t)(row0 - 30 + rr) * 256 + 4 * lane);
        hv[rr] = w;
    }
#pragma unroll
    for (int j = 0; j < 31; ++j) {
        const f32x4 wj = *(const LAS f32x4*)(wlds + j * 256 + 4 * lane);
#pragma unroll
        for (int tt = 0; tt < 4; ++tt) {
            const u32x2 w = hv[tt + j];
            acc[tt][0] += wj.x * bflo(w.x); acc[tt][1] += wj.y * bfhi(w.x); acc[tt][2] += wj.z * bflo(w.y); acc[tt][3] += wj.w * bfhi(w.y);
        }
    }
    const f32x4 gv = *(const f32x4*)(ln_g + 4 * lane), bv2 = *(const f32x4*)(ln_b + 4 * lane);
#pragma unroll
    for (int tt = 0; tt < 4; ++tt) {
        const float mean = wave_sum((acc[tt][0] + acc[tt][1]) + (acc[tt][2] + acc[tt][3])) * (1.f / 256.f);
        const float d0 = acc[tt][0] - mean, d1 = acc[tt][1] - mean, d2 = acc[tt][2] - mean, d3 = acc[tt][3] - mean;
        const float var = wave_sum((d0 * d0 + d1 * d1) + (d2 * d2 + d3 * d3)) * (1.f / 256.f);
        const float rstd = __builtin_amdgcn_rsqf(var + EPS);
        float y0 = d0 * rstd * gv.x + bv2.x, y1 = d1 * rstd * gv.y + bv2.y, y2 = d2 * rstd * gv.z + bv2.z, y3 = d3 * rstd * gv.w + bv2.w;
        y0 *= sigmoidf_(y0); y1 *= sigmoidf_(y1); y2 *= sigmoidf_(y2); y3 *= sigmoidf_(y3);
        u32x2 w; w.x = cvt_pk_bf16(y0, y1); w.y = cvt_pk_bf16(y2, y3);
        *(u32x2*)(AC + (size_t)(row0 + tt) * 256 + 4 * lane) = w;
    }
}

struct SsmW { const float *lam_re, *lam_im, *log_dt, *b_re, *b_im, *c_re, *c_im, *dsk; };
__device__ __forceinline__ u32x4 pack8(const float* v) { u32x4 w; w.x = cvt_pk_bf16(v[0], v[1]); w.y = cvt_pk_bf16(v[2], v[3]); w.z = cvt_pk_bf16(v[4], v[5]); w.w = cvt_pk_bf16(v[6], v[7]); return w; }
template <bool PASSC>
__device__ __forceinline__ void ssm_task(int task, const SsmW& W, const bf16_t* U, f32x2* SST, bf16_t* YS, LAS unsigned char* wl, int lane) {
    const int g = (task >> 7) & 15, b = task >> 11;
    const int c = b ? 127 - (task & 127) : (task & 127);
    const size_t tok0 = (size_t)b * SEQ + c * 64;
    LAS unsigned char* BU = wl;
    LAS unsigned char* xb = wl + 8320;
    const int hh = lane & 15, kq = lane >> 4;
    const float lr = W.lam_re[g * 64 + lane], li = W.lam_im[g * 64 + lane], dt = __expf(W.log_dt[g]);
    const float mag = __expf(lr * dt);
    float sn, cs; { const float ang = li * dt; const float kk = rintf(ang * 0.15915494309189535f); float rr = fmaf(-kk, 6.28125f, ang); rr = fmaf(-kk, 1.9353071795864769e-3f, rr); sn = __sinf(rr); cs = __cosf(rr); }
    const float ar = mag * cs, ai = mag * sn;
    const float den = lr * lr + li * li;
    const float fr = ((ar - 1.f) * lr + ai * li) / den, fi = (ai * lr - (ar - 1.f) * li) / den;
    {
        float bbr[16], bbi[16];
        const f32x4* brp = (const f32x4*)(W.b_re + (size_t)(g * 64 + lane) * 16); const f32x4* bip = (const f32x4*)(W.b_im + (size_t)(g * 64 + lane) * 16);
#pragma unroll
        for (int q = 0; q < 4; ++q) { const f32x4 br = brp[q], bi = bip[q];
#pragma unroll
            for (int j = 0; j < 4; ++j) { bbr[4 * q + j] = fr * br[j] - fi * bi[j]; bbi[4 * q + j] = fr * bi[j] + fi * br[j]; } }
        LAS u32x4* t = (LAS u32x4*)(BU + lane * 64);
        t[0] = pack8(bbr); t[1] = pack8(bbr + 8); t[2] = pack8(bbi); t[3] = pack8(bbi + 8);
    }
    asm volatile("s_waitcnt lgkmcnt(0)" ::: "memory");
    const bf16x8 zfrag = (bf16x8){0, 0, 0, 0, 0, 0, 0, 0};
    bf16x8 bfr[8];
#pragma unroll
    for (int nb = 0; nb < 8; ++nb) bfr[nb] = (kq < 2) ? *(const LAS bf16x8*)(BU + (16 * nb + hh) * 32 + kq * 16) : zfrag;
    bf16x8 cf[4];
    if (PASSC) {
#pragma unroll
        for (int ks = 0; ks < 4; ++ks) {
            const int p0 = 16 * ks + 4 * kq;
            const f32x4 cre = *(const f32x4*)(W.c_re + (size_t)(g * 16 + hh) * 64 + p0), cim = *(const f32x4*)(W.c_im + (size_t)(g * 16 + hh) * 64 + p0);
            u32x4 cw; cw.x = cvt_pk_bf16(cre[0], -cim[0]); cw.y = cvt_pk_bf16(cre[1], -cim[1]); cw.z = cvt_pk_bf16(cre[2], -cim[2]); cw.w = cvt_pk_bf16(cre[3], -cim[3]);
            cf[ks] = __builtin_bit_cast(bf16x8, cw);
        }
    }
    float xr = 0.f, xi = 0.f;
    if (PASSC) {
        float tr = ar, ti = ai;
#pragma unroll
        for (int i = 0; i < 6; ++i) { const float nr = tr * tr - ti * ti, ni = 2.f * tr * ti; tr = nr; ti = ni; }
        const f32x2* sp = SST + ((size_t)(b * 16 + g) * 128) * 64 + lane;
        for (int j0 = 0; j0 < c; j0 += 16) {
            f32x2 sv[16];
#pragma unroll
            for (int q = 0; q < 16; ++q) sv[q] = (j0 + q < c) ? sp[(size_t)(j0 + q) * 64] : (f32x2){0.f, 0.f};
#pragma unroll
            for (int q = 0; q < 16; ++q) if (j0 + q < c) { const float nr = tr * xr - ti * xi + sv[q].x, ni = tr * xi + ti * xr + sv[q].y; xr = nr; xi = ni; }
        }
    }
    const float dk = PASSC ? W.dsk[g * 16 + hh] : 0.f;
    asm volatile("s_waitcnt lgkmcnt(0)" ::: "memory");
#pragma unroll 1
    for (int blk = 0; blk < 4; ++blk) {
        const bf16_t* ub = U + (tok0 + blk * 16) * 256 + g * 16;
        bf16x8 af = zfrag;
        if (kq < 2) af = *(const bf16x8*)(ub + (size_t)hh * 256 + kq * 8);
#pragma unroll
        for (int nb = 0; nb < 8; ++nb) {
            const f32x4 d = MFMA16(af, bfr[nb], ((f32x4){0.f, 0.f, 0.f, 0.f}));
#pragma unroll
            for (int i = 0; i < 4; ++i) *(LAS float*)(BU + (4 * kq + i) * 520 + (16 * nb + hh) * 4) = d[i];
        }
        asm volatile("s_waitcnt lgkmcnt(0)" ::: "memory");
#pragma unroll
        for (int s = 0; s < 16; ++s) {
            const f32x2 bu = *(const LAS f32x2*)(BU + s * 520 + 8 * lane);
            const float nr = ar * xr - ai * xi + bu.x, ni = ar * xi + ai * xr + bu.y; xr = nr; xi = ni;
            if (PASSC) *(LAS unsigned*)(xb + s * 272 + 4 * lane) = cvt_pk_bf16(xr, xi);
        }
        if (PASSC) {
            asm volatile("s_waitcnt lgkmcnt(0)" ::: "memory");
            f32x4 y = (f32x4){0.f, 0.f, 0.f, 0.f};
#pragma unroll
            for (int ks = 0; ks < 4; ++ks) { const bf16x8 a0 = *(const LAS bf16x8*)(xb + hh * 272 + 64 * ks + 16 * kq); y = MFMA16(a0, cf[ks], y); }
#pragma unroll
            for (int i = 0; i < 4; ++i) {
                const size_t e = (size_t)(4 * kq + i) * 256 + hh;
                YS[(tok0 + blk * 16) * 256 + g * 16 + e] = f2bf(y[i] + dk * bf2f(ub[e]));
            }
        }
        asm volatile("s_waitcnt lgkmcnt(0)" ::: "memory");
    }
    if (!PASSC) SST[((size_t)(b * 16 + g) * 128 + c) * 64 + lane] = (f32x2){xr, xi};
}

template <bool PASSC>
__device__ __forceinline__ void ssm_task_old(int task, const SsmW& W, const bf16_t* U, f32x2* SST, bf16_t* YS, LAS unsigned char* wl, int lane) {
    const int c = task & 127, g = (task >> 7) & 15, b = task >> 11;
    const size_t tok0 = (size_t)b * SEQ + c * 64;
    LAS float* uL = (LAS float*)wl;
    LAS unsigned char* xb = wl + 4096;
    {
        const u32x4* up = (const u32x4*)(U + (tok0 + lane) * 256 + g * 16);
        const u32x4 w0 = up[0], w1 = up[1];
        LAS f32x4* d = (LAS f32x4*)(uL + lane * 16);
        d[0] = (f32x4){bflo(w0.x), bfhi(w0.x), bflo(w0.y), bfhi(w0.y)}; d[1] = (f32x4){bflo(w0.z), bfhi(w0.z), bflo(w0.w), bfhi(w0.w)};
        d[2] = (f32x4){bflo(w1.x), bfhi(w1.x), bflo(w1.y), bfhi(w1.y)}; d[3] = (f32x4){bflo(w1.z), bfhi(w1.z), bflo(w1.w), bfhi(w1.w)};
    }
    const float lr = W.lam_re[g * 64 + lane], li = W.lam_im[g * 64 + lane], dt = __expf(W.log_dt[g]);
    const float mag = __expf(lr * dt);
    float sn, cs; { const float ang = li * dt; const float kq = rintf(ang * 0.15915494309189535f); float rr = fmaf(-kq, 6.28125f, ang); rr = fmaf(-kq, 1.9353071795864769e-3f, rr); sn = __sinf(rr); cs = __cosf(rr); }
    const float ar = mag * cs, ai = mag * sn;
    const float den = lr * lr + li * li;
    const float fr = ((ar - 1.f) * lr + ai * li) / den, fi = (ai * lr - (ar - 1.f) * li) / den;
    float bbr[16], bbi[16];
    { const f32x4* brp = (const f32x4*)(W.b_re + (size_t)(g * 64 + lane) * 16); const f32x4* bip = (const f32x4*)(W.b_im + (size_t)(g * 64 + lane) * 16);
#pragma unroll
      for (int q = 0; q < 4; ++q) { const f32x4 br = brp[q], bi = bip[q];
#pragma unroll
          for (int j = 0; j < 4; ++j) { bbr[4 * q + j] = fr * br[j] - fi * bi[j]; bbi[4 * q + j] = fr * bi[j] + fi * br[j]; } } }
    float xr = 0.f, xi = 0.f;
    if (PASSC) {
        float tr = ar, ti = ai;
#pragma unroll
        for (int i = 0; i < 6; ++i) { const float nr = tr * tr - ti * ti, ni = 2.f * tr * ti; tr = nr; ti = ni; }
        const f32x2* sp = SST + ((size_t)(b * 16 + g) * 128) * 64 + lane;
        for (int j0 = 0; j0 < c; j0 += 16) {
            f32x2 sv[16];
#pragma unroll
            for (int q = 0; q < 16; ++q) sv[q] = (j0 + q < c) ? sp[(size_t)(j0 + q) * 64] : (f32x2){0.f, 0.f};
#pragma unroll
            for (int q = 0; q < 16; ++q) if (j0 + q < c) { const float nr = tr * xr - ti * xi + sv[q].x, ni = tr * xi + ti * xr + sv[q].y; xr = nr; xi = ni; }
        }
    }
    asm volatile("s_waitcnt lgkmcnt(0)" ::: "memory");
#pragma unroll 1
    for (int half = 0; half < 2; ++half) {
#pragma unroll 4
        for (int s = 0; s < 32; ++s) {
            const LAS f32x4* ur = (const LAS f32x4*)(uL + (half * 32 + s) * 16);
            float br_ = 0.f, bi_ = 0.f;
#pragma unroll
            for (int q = 0; q < 4; ++q) { const f32x4 uv = ur[q];
#pragma unroll
                for (int j = 0; j < 4; ++j) { br_ = fmaf(bbr[4 * q + j], uv[j], br_); bi_ = fmaf(bbi[4 * q + j], uv[j], bi_); } }
            const float nr = ar * xr - ai * xi + br_, ni = ar * xi + ai * xr + bi_; xr = nr; xi = ni;
            if (PASSC) *(LAS unsigned*)(xb + s * 272 + 4 * lane) = cvt_pk_bf16(xr, xi);
        }
        if (PASSC) {
            asm volatile("s_waitcnt lgkmcnt(0)" ::: "memory");
            const int hh = lane & 15, kq = lane >> 4;
            f32x4 y0 = (f32x4){0.f, 0.f, 0.f, 0.f}, y1 = y0;
#pragma unroll
            for (int ks = 0; ks < 4; ++ks) {
                const int p0 = 16 * ks + 4 * kq;
                const f32x4 cre = *(const f32x4*)(W.c_re + (size_t)(g * 16 + hh) * 64 + p0), cim = *(const f32x4*)(W.c_im + (size_t)(g * 16 + hh) * 64 + p0);
                u32x4 cw; cw.x = cvt_pk_bf16(cre[0], -cim[0]); cw.y = cvt_pk_bf16(cre[1], -cim[1]); cw.z = cvt_pk_bf16(cre[2], -cim[2]); cw.w = cvt_pk_bf16(cre[3], -cim[3]);
                const bf16x8 cf = __builtin_bit_cast(bf16x8, cw);
                const bf16x8 a0 = *(const LAS bf16x8*)(xb + (lane & 15) * 272 + 64 * ks + 16 * kq);
                const bf16x8 a1 = *(const LAS bf16x8*)(xb + (16 + (lane & 15)) * 272 + 64 * ks + 16 * kq);
                y0 = MFMA16(a0, cf, y0); y1 = MFMA16(a1, cf, y1);
            }
            const float dk = W.dsk[g * 16 + hh];
#pragma unroll
            for (int i = 0; i < 4; ++i) {
                const int s0 = 4 * kq + i, s1 = 16 + 4 * kq + i;
                const float v0 = y0[i] + dk * uL[(half * 32 + s0) * 16 + hh], v1 = y1[i] + dk * uL[(half * 32 + s1) * 16 + hh];
                YS[(tok0 + half * 32 + s0) * 256 + g * 16 + hh] = f2bf(v0);
                YS[(tok0 + half * 32 + s1) * 256 + g * 16 + hh] = f2bf(v1);
            }
            asm volatile("s_waitcnt lgkmcnt(0)" ::: "memory");
        }
    }
    if (!PASSC) SST[((size_t)(b * 16 + g) * 128 + c) * 64 + lane] = (f32x2){xr, xi};
}

__device__ __forceinline__ void knorm_task(int task, const float* kraw, const float* kg_all, const float* qg_all, bf16_t* KP, int lane) {
    const int head = task & 3, row = (task >> 2) & 511, lay = task >> 11;
    const f32x4 v = *(const f32x4*)(kraw + ((size_t)lay * 512 + row) * 1024 + head * 256 + 4 * lane);
    const float ss = wave_sum((v.x * v.x + v.y * v.y) + (v.z * v.z + v.w * v.w));
    const float rs = __builtin_amdgcn_rsqf(ss * (1.f / 256.f) + EPS);
    const f32x4 kg = *(const f32x4*)(kg_all + lay * 256 + 4 * lane), qg = *(const f32x4*)(qg_all + lay * 256 + 4 * lane);
    const int b = row >> 8, mt = row & 255;
    u32x2 w; w.x = cvt_pk_bf16(v.x * rs * kg.x * qg.x, v.y * rs * kg.y * qg.y); w.y = cvt_pk_bf16(v.z * rs * kg.z * qg.z, v.w * rs * kg.w * qg.w);
    *(u32x2*)(KP + ((size_t)((lay * 2 + b) * 4 + head) * 256 + mt) * 256 + 4 * lane) = w;
}

__device__ __forceinline__ void xa_task(int task, const bf16_t* XQ, const bf16_t* KPl, const bf16_t* VTMl, bf16_t* XO, int lane) {
    const int r32 = lane & 31, hi = lane >> 5;
    const int qb = task & 255, head = (task >> 8) & 3, b = task >> 10;
    const size_t rowbase = (size_t)b * SEQ; const int q0 = qb * 32;
    float ssq = 0.f;
    const bf16_t* qp = XQ + (rowbase + q0 + r32) * 1024 + head * 256 + hi * 8;
#pragma unroll
    for (int ks = 0; ks < 16; ++ks) { const bf16x8 qv = *(const bf16x8*)(qp + ks * 16);
#pragma unroll
        for (int j = 0; j < 8; ++j) { const float f = bf2f((unsigned short)qv[j]); ssq += f * f; } }
    ssq += xshfl<32>(ssq);
    const float rq = __builtin_amdgcn_rsqf(ssq * (1.f / 256.f) + EPS) * (0.0625f * LOG2E);
    const bf16_t* kbase = KPl + ((size_t)(b * 4 + head) * 256 + r32) * 256 + hi * 8;
    f32x16 sc[8];
#pragma unroll
    for (int kb = 0; kb < 8; ++kb) {
        f32x16 s;
#pragma unroll
        for (int r = 0; r < 16; ++r) s[r] = 0.f;
#pragma unroll
        for (int ks = 0; ks < 16; ++ks) { const bf16x8 kf = *(const bf16x8*)(kbase + (size_t)kb * 32 * 256 + ks * 16); const bf16x8 qv = *(const bf16x8*)(qp + ks * 16); s = MFMA32(kf, qv, s); }
        sc[kb] = s * rq;
        asm volatile("" ::: "memory");
    }
    float mx = -3.0e38f;
#pragma unroll
    for (int kb = 0; kb < 8; ++kb)
#pragma unroll
        for (int r = 0; r < 16; ++r) mx = fmaxf(mx, sc[kb][r]);
    mx = fmaxf(mx, xshfl<32>(mx));
    float sum = 0.f;
#pragma unroll
    for (int kb = 0; kb < 8; ++kb)
#pragma unroll
        for (int r = 0; r < 16; ++r) { const float p = ex2(sc[kb][r] - mx); sc[kb][r] = p; sum += p; }
    sum += xshfl<32>(sum);
    const float inv = __builtin_amdgcn_rcpf(sum);
    bf16x8 pa[8][2];
#pragma unroll
    for (int kb = 0; kb < 8; ++kb)
#pragma unroll
        for (int j = 0; j < 2; ++j) { u32x4 p; p.x = cvt_pk_bf16(sc[kb][8 * j] * inv, sc[kb][8 * j + 1] * inv); p.y = cvt_pk_bf16(sc[kb][8 * j + 2] * inv, sc[kb][8 * j + 3] * inv);
            p.z = cvt_pk_bf16(sc[kb][8 * j + 4] * inv, sc[kb][8 * j + 5] * inv); p.w = cvt_pk_bf16(sc[kb][8 * j + 6] * inv, sc[kb][8 * j + 7] * inv); pa[kb][j] = __builtin_bit_cast(bf16x8, p); }
    const bf16_t* vbase = VTMl + ((size_t)(b * 4 + head) * 256 + r32) * 256 + 4 * hi;
#pragma unroll 1
    for (int db = 0; db < 8; ++db) {
        f32x16 o;
#pragma unroll
        for (int r = 0; r < 16; ++r) o[r] = 0.f;
        const bf16_t* vp = vbase + (size_t)db * 32 * 256;
#pragma unroll
        for (int kb = 0; kb < 8; ++kb)
#pragma unroll
            for (int j = 0; j < 2; ++j) {
                const s16x4 lo = *(const s16x4*)(vp + kb * 32 + 16 * j), hi4 = *(const s16x4*)(vp + kb * 32 + 16 * j + 8);
                const bf16x8 vf = (bf16x8){lo[0], lo[1], lo[2], lo[3], hi4[0], hi4[1], hi4[2], hi4[3]};
                o = MFMA32(pa[kb][j], vf, o);
            }
#pragma unroll
        for (int r = 0; r < 16; ++r) XO[(rowbase + q0 + crow(r, hi)) * 1024 + head * 256 + db * 32 + r32] = f2bf(o[r]);
    }
}

#define XB_TMO      128
#define XB_XCNT(j)  (256  + 64 * (j))
#define XB_XSUB(j)  (1280 + 64 * (j))
#define XB_XGEN(j)  (2304 + 64 * (j))
#define XB_TOP      3328
#define XB_TOPGEN   3392
#define XCD_BAR_WORDS 3456
#define XB_SPIN_CAP (1u << 18)

__device__ __forceinline__ unsigned xb_ld(unsigned* p)              { return __hip_atomic_load(p, __ATOMIC_RELAXED, __HIP_MEMORY_SCOPE_AGENT); }
__device__ __forceinline__ unsigned xb_add(unsigned* p, unsigned v) { return __hip_atomic_fetch_add(p, v, __ATOMIC_RELAXED, __HIP_MEMORY_SCOPE_AGENT); }
__device__ __forceinline__ unsigned xb_xcc_id() { return (unsigned)__builtin_amdgcn_s_getreg((3 << 11) | 20) & 0xFu; }
#define XB_SPIN(cond, bar) do { unsigned _sp = 0; while (cond) { __builtin_amdgcn_s_sleep(1); \
    if ((++_sp & 255u) == 0u) { if (xb_ld(&(bar)[XB_TMO])) break; if (_sp > XB_SPIN_CAP) { atomicAdd(&(bar)[XB_TMO], 1u); break; } } } } while (0)

struct XcdBarrier {
    unsigned* bar; unsigned x;
    volatile LAS unsigned* st;
};

__device__ __forceinline__ XcdBarrier xcd_barrier_post(unsigned* bar, volatile LAS unsigned* st) {
    XcdBarrier b; b.bar = bar; b.x = xb_xcc_id(); b.st = st;
    if (threadIdx.x == 0) (void)xb_add(&bar[XB_XCNT(b.x)], 1u);
    return b;
}
__device__ __forceinline__ void xcd_barrier_complete(unsigned* bar, unsigned x, unsigned& nloc, unsigned& nx) {
    const unsigned G = gridDim.x * gridDim.y * gridDim.z;
    unsigned sum, cnt, mine, sp = 0u;
    for (;;) {
        sum = 0u; cnt = 0u; mine = 0u;
#pragma unroll
        for (unsigned j = 0; j < 16; ++j) { const unsigned c = xb_ld(&bar[XB_XCNT(j)]); sum += c; cnt += (c > 0u) ? 1u : 0u; mine = (j == x) ? c : mine; }
        if (sum == G) break;
        __builtin_amdgcn_s_sleep(1);
        if ((++sp & 255u) == 0u) { if (xb_ld(&bar[XB_TMO])) break; if (sp > XB_SPIN_CAP) { atomicAdd(&bar[XB_TMO], 1u); break; } }
    }
    nloc = mine > 0u ? mine : 1u; nx = cnt > 0u ? cnt : 1u;
}

__device__ __forceinline__ void xcd_barrier(const XcdBarrier& b) {
    asm volatile("s_waitcnt vmcnt(0)" ::: "memory");
    __syncthreads();
    if (threadIdx.x == 0) {
        unsigned* bar = b.bar;
        unsigned bx = (unsigned)__builtin_amdgcn_readfirstlane((int)b.x); asm volatile("" : "+s"(bx));
        __builtin_amdgcn_s_waitcnt(0);
        unsigned nloc = b.st[0], nx = b.st[1];
        if (nloc == 0u) { xcd_barrier_complete(bar, bx, nloc, nx); b.st[0] = nloc; b.st[1] = nx; }
        const unsigned old = xb_add(&bar[XB_XSUB(bx)], 1u);
        const unsigned gen = old / nloc;
        if (old + 1u == (gen + 1u) * nloc) {
            __builtin_amdgcn_fence(__ATOMIC_RELEASE, "agent");
            asm volatile("s_waitcnt vmcnt(0)" ::: "memory");
            const unsigned og = xb_add(&bar[XB_TOP], 1u);
            const unsigned tg = og / nx;
            if (og + 1u == (tg + 1u) * nx) xb_add(&bar[XB_TOPGEN], 1u);
            else XB_SPIN(xb_ld(&bar[XB_TOPGEN]) == tg, bar);
            __builtin_amdgcn_fence(__ATOMIC_ACQUIRE, "agent");
            xb_add(&bar[XB_XGEN(bx)], 1u);
            asm volatile("s_waitcnt vmcnt(0)" ::: "memory");
        } else {
            XB_SPIN(xb_ld(&bar[XB_XGEN(bx)]) == gen, bar);
            __builtin_amdgcn_fence(__ATOMIC_ACQUIRE, "agent");
            asm volatile("s_waitcnt vmcnt(0)" ::: "memory");
        }
    }
    __syncthreads();
}


#ifndef REP_SYNC
#define REP_SYNC 0
#endif
#ifndef REP_PRO
#define REP_PRO 0
#endif
#ifndef REP_XA
#define REP_XA 0
#endif
#ifndef REP_SB
#define REP_SB 0
#endif
#ifndef REP_CONV
#define REP_CONV 0
#endif
#ifndef REP_SSMA
#define REP_SSMA 0
#endif
#ifndef REP_PA
#define REP_PA 0
#endif
#ifndef REP_PJ
#define REP_PJ 0
#endif
#ifndef REP_PC
#define REP_PC 0
#endif
#define GSYNC() do { xcd_barrier(xbar); for (int r_ = 0; r_ < REP_SYNC; ++r_) xcd_barrier(xbar); } while (0)
__global__ void __launch_bounds__(NWAVES * 64, 2) fwd_kernel(KArgs a) {
    extern __shared__ __attribute__((aligned(16))) unsigned char lds_raw[];
    LAS unsigned char* lds = (LAS unsigned char*)lds_raw;
    cg::grid_group grid = cg::this_grid();
    const int wave = __builtin_amdgcn_readfirstlane((int)threadIdx.x >> 6);
    const int G = gridDim.x, vcu = (G % 8 == 0) ? ((int)blockIdx.x % 8) * (G / 8) + (int)blockIdx.x / 8 : (int)blockIdx.x;
    const int gw = vcu * NWAVES + wave, NGW = G * NWAVES;
#define PHASE_PTRS() unsigned char* ws = argp(lds, 34); const int ln = lane_id_asm(); int gwl = launder_i(gw); (void)ln; (void)gwl; unsigned char* wl = ws + WS_W + (size_t)l * WL_STRIDE; (void)wl; \
    bf16_t* XB = (bf16_t*)(ws + WS_XB); bf16_t* Qb = (bf16_t*)(ws + WS_Q); bf16_t* Kb = (bf16_t*)(ws + WS_K); bf16_t* Vt = (bf16_t*)(ws + WS_VT); \
    bf16_t* HC = (bf16_t*)(ws + WS_HC); bf16_t* Ub = (bf16_t*)(ws + WS_U); bf16_t* AC = (bf16_t*)(ws + WS_AC); bf16_t* YS = (bf16_t*)(ws + WS_YS); \
    float* KRAW = (float*)(ws + WS_KRAW); bf16_t* HF = (bf16_t*)(ws + WS_HF); bf16_t* MIX = (bf16_t*)(ws + WS_MIX); bf16_t* XO = (bf16_t*)AOUT(); \
    f32x2* SST = (f32x2*)(ws + WS_SST); bf16_t* KP = (bf16_t*)(ws + WS_KP); bf16_t* VTM = (bf16_t*)(ws + WS_VTM); bf16_t* HMN = (bf16_t*)(ws + WS_HMN); \
    (void)XB; (void)Qb; (void)Kb; (void)Vt; (void)HC; (void)Ub; (void)AC; (void)YS; (void)KRAW; (void)HF; (void)MIX; (void)XO; (void)SST; (void)KP; (void)VTM; (void)HMN;

    if (threadIdx.x < 2) ((volatile LAS unsigned*)(lds + XBST_OFF))[threadIdx.x] = 0u;
    __syncthreads();
    XcdBarrier xbar = xcd_barrier_post((unsigned*)(a.ws + WS_BAR), (volatile LAS unsigned*)(lds + XBST_OFF));
    if (threadIdx.x == 0) {
        volatile LAS unsigned long long* ap = (volatile LAS unsigned long long*)(lds + ARGS_OFF);
#pragma unroll
        for (int i = 0; i < 33; ++i) ap[i] = (unsigned long long)a.in[i];
        ap[33] = (unsigned long long)a.out; ap[34] = (unsigned long long)a.ws;
    }
#ifndef SKIP_PRO
    __syncthreads();
    for (int r_ = 0; r_ <= REP_PRO; ++r_) prologue(a, lds, gw, NGW, wave, lane_id_asm());
#endif
    __syncthreads();
    if (a.ws == nullptr) grid.sync();
    GSYNC();

    for (int l = 0; l < DEPTH; ++l) {
        {
            PHASE_PTRS();
            pg8::Sched S; S.A0 = (const char*)XB; S.B0 = (const char*)(wl + WL_IN); S.nM0 = M / 256; S.nN0 = NIN / 256;
            S.A1 = (const char*)HMN; S.B1 = (const char*)(ws + WS_WKV); S.nM1 = 2; S.nN1 = 16; S.np = (l == 0) ? 2 : 1; S.K = DM; S.G = G; S.c = launder_i(blockIdx.x);
            EpiIn E{ws, l, AIN(4) + l * 64, AIN(5) + l * 64};
#if !defined(SKIP_GEMM) && (!defined(GSEL) || (GSEL & 1))
            for (int r_ = 0; r_ < REP_PA; ++r_) pg8::gemm_phase(lds, S, E, wave);
            pg8::gemm_phase(lds, S, E, wave);
#endif
            if (l == 0) {
                const int first = (G > 96) ? 96 : 0, nb = G - first;
                if ((int)blockIdx.x >= first) {
                    const int ln5 = lane_id_asm(); LAS float* scr = (LAS float*)(lds + wave * 16384);
                    for (int d = ((int)blockIdx.x - first) * NWAVES + wave; d < CI_DSPLIT; d += nb * NWAVES) convert_deferred(lds, ws, d, scr, ln5);
                }
            }
        }
        GSYNC();
        {
            PHASE_PTRS();
            #ifndef SKIP_SB
            { const float* dw = AIN(6) + l * 31 * 256; const int tl = wave * 64 + ln;
              for (int i = tl; i < 31 * 64; i += NWAVES * 64) ((LAS f32x4*)lds)[i] = ((const f32x4*)dw)[i];
              __syncthreads(); }
            for (int r_ = 0; r_ <= REP_SB; ++r_) { const int ln1 = lane_id_asm(); for (int t = gwl; t < 4096; t += NGW) sb_task(t, Qb, Kb, Vt, MIX, SSP(l, SS_SB), ln1, r_ == 0); }
#endif
#ifndef SKIP_CONV
            for (int r_ = 0; r_ <= REP_CONV; ++r_) { const int ln2 = lane_id_asm(); for (int t = gwl; t < M / 4; t += NGW) conv_task(t, HC, (const LAS float*)lds, AIN(7) + l * 256, AIN(8) + l * 256, AIN(9) + l * 256, AC, ln2); }
#endif
            __syncthreads();
            SsmW W{AIN(11) + l * 1024, AIN(12) + l * 1024, AIN(13) + l * 16, AIN(14) + (size_t)l * 16384, AIN(15) + (size_t)l * 16384, AIN(16) + (size_t)l * 16384, AIN(17) + (size_t)l * 16384, AIN(18) + l * 256};
#ifndef SKIP_SSM
            for (int r_ = 0; r_ <= REP_SSMA; ++r_) { const int ln3 = lane_id_asm(); for (int t = gwl; t < 4096; t += NGW) ssm_task_old<false>(t, W, Ub, SST, YS, lds + wave * 16384, ln3); }
#endif
            if (l == 0) { const int ln4 = lane_id_asm(); for (int t = gwl; t < 4096; t += NGW) knorm_task(t, KRAW, AIN(28), AIN(27), KP, ln4); }
        }
        GSYNC();
        {
            PHASE_PTRS();
            SsmW W{AIN(11) + l * 1024, AIN(12) + l * 1024, AIN(13) + l * 16, AIN(14) + (size_t)l * 16384, AIN(15) + (size_t)l * 16384, AIN(16) + (size_t)l * 16384, AIN(17) + (size_t)l * 16384, AIN(18) + l * 256};
#ifndef SKIP_SSM
            for (int r_ = 0; r_ <= REP_PC; ++r_) for (int t = gwl; t < 4096; t += NGW) ssm_task<true>(t, W, Ub, SST, YS, lds + wave * 16384, ln);
#endif
        }
        GSYNC();
        {
            PHASE_PTRS();
            pg8::Sched S; S.A0 = (const char*)AC; S.B0 = (const char*)(wl + WL_PW2); S.nM0 = M / 256; S.nN0 = 1;
            S.A1 = (const char*)YS; S.B1 = (const char*)(wl + WL_GLU); S.nM1 = M / 256; S.nN1 = 2; S.np = 2; S.K = 256; S.G = G; S.c = launder_i(blockIdx.x);
            EpiPwGlu E{ws, l};
#if !defined(SKIP_GEMM) && (!defined(GSEL) || (GSEL & 2))
            pg8::gemm_phase(lds, S, E, wave);
#endif
        }
        GSYNC();
        {
            PHASE_PTRS();
            pg8::Sched S; S.A0 = (const char*)MIX; S.B0 = (const char*)(wl + WL_OUT); S.nM0 = M / 256; S.nN0 = 4; S.A1 = nullptr; S.B1 = nullptr; S.nM1 = 0; S.nN1 = 0; S.np = 1; S.K = DM; S.G = G; S.c = launder_i(blockIdx.x);
            EpiRes E{nullptr, ws, l * 6 + SS_XA, (const LAS float*)(lds + EX_OFF)};
            { pg8::Unit u0; const int tl = wave * 64 + ln;
              if (S.next(0, u0) && tl < 256) {
                  const int row = u0.pm * 256 + tl;
                  const float r1 = __builtin_amdgcn_rsqf(SSP(l, SS_SB)[row] * (1.f / 512.f) + EPS), r2 = __builtin_amdgcn_rsqf(SSP(l, SS_CONV)[row] * (1.f / 256.f) + EPS), r3 = __builtin_amdgcn_rsqf(SSP(l, SS_SSM)[row] * (1.f / 256.f) + EPS);
                  LAS float* fac = (LAS float*)(lds + EX_OFF) + tl * 4;
                  fac[0] = r1 / r2; fac[1] = r2 / r3; fac[2] = r3; }
              __syncthreads(); }
#if !defined(SKIP_GEMM) && (!defined(GSEL) || (GSEL & 4))
            pg8::gemm_phase(lds, S, E, wave, pg8::HookMix{(const LAS float*)(lds + EX_OFF)});
#endif
        }
        GSYNC();
        {
            PHASE_PTRS();
            pg8::Sched S; S.A0 = (const char*)XB; S.B0 = (const char*)(wl + WL_Q); S.nM0 = M / 256; S.nN0 = 4; S.A1 = nullptr; S.B1 = nullptr; S.nM1 = 0; S.nN1 = 0; S.np = 1; S.K = DM; S.G = G; S.c = launder_i(blockIdx.x);
            EpiQ E{ws, l};
#if !defined(SKIP_GEMM) && (!defined(GSEL) || (GSEL & 8))
            pg8::gemm_phase(lds, S, E, wave);
#endif
        }
        if (launder_i(G) != 256) { GSYNC(); }
        else {
            asm volatile("s_waitcnt vmcnt(0)" ::: "memory"); __syncthreads();
            if (threadIdx.x == 0) { __builtin_amdgcn_fence(__ATOMIC_ACQUIRE, "agent"); asm volatile("s_waitcnt vmcnt(0)" ::: "memory"); }
            __syncthreads();
        }
        {
            PHASE_PTRS();
            pg8::SchedXA S; S.A = (const char*)MIX; S.B = (const char*)(KP + (size_t)l * 2 * 4 * 256 * 256); S.K = 256; S.G = G; S.c = launder_i(blockIdx.x);
            EpiSm E{ws, l, lds};
#if !defined(SKIP_GEMM)
            pg8::gemm_phase(lds, S, E, wave);
#endif
        }
        asm volatile("s_waitcnt vmcnt(0)" ::: "memory"); __syncthreads();
        if (threadIdx.x == 0) { __builtin_amdgcn_fence(__ATOMIC_ACQUIRE, "agent"); asm volatile("s_waitcnt vmcnt(0)" ::: "memory"); }
        __syncthreads();
        {
            PHASE_PTRS();
            pg8::SchedXA S; S.A = (const char*)HF; S.B = (const char*)(VTM + (size_t)l * 2 * 4 * 256 * 256); S.K = 256; S.G = G; S.c = launder_i(blockIdx.x);
            EpiPlain E{(unsigned char*)AOUT(), 0};
#if !defined(SKIP_GEMM)
            pg8::gemm_phase(lds, S, E, wave);
#endif
        }
        GSYNC();
        {
            PHASE_PTRS();
            pg8::Sched S; S.A0 = (const char*)XO; S.B0 = (const char*)(wl + WL_O); S.nM0 = M / 256; S.nN0 = 4; S.A1 = nullptr; S.B1 = nullptr; S.nM1 = 0; S.nN1 = 0; S.np = 1; S.K = DM; S.G = G; S.c = launder_i(blockIdx.x);
            EpiRes E{nullptr, ws, l * 6 + SS_FFN, nullptr};
#if !defined(SKIP_GEMM) && (!defined(GSEL) || (GSEL & 16))
            pg8::gemm_phase(lds, S, E, wave);
#endif
        }
        GSYNC();
        {
            PHASE_PTRS();
            pg8::Sched S; S.A0 = (const char*)XB; S.B0 = (const char*)(wl + WL_FFI); S.nM0 = M / 256; S.nN0 = 2 * FFH / 256; S.A1 = nullptr; S.B1 = nullptr; S.nM1 = 0; S.nN1 = 0; S.np = 1; S.K = DM; S.G = G; S.c = launder_i(blockIdx.x);
            EpiFfn E{ws, l};
#if !defined(SKIP_GEMM) && (!defined(GSEL) || (GSEL & 32))
            for (int r_ = 0; r_ < REP_PJ; ++r_) pg8::gemm_phase(lds, S, E, wave);
            pg8::gemm_phase(lds, S, E, wave);
#endif
            if (l == 0) {
                const int first = (G > 128) ? 128 : 0, nb = G - first;
                if ((int)blockIdx.x >= first) {
                    const int ln5 = lane_id_asm(); LAS float* scr = (LAS float*)(lds + wave * 16384);
                    for (int d = CI_DSPLIT + ((int)blockIdx.x - first) * NWAVES + wave; d < CI_DTOT; d += nb * NWAVES) convert_deferred(lds, ws, d, scr, ln5);
                }
            }
        }
        GSYNC();
        {
            PHASE_PTRS();
            pg8::Sched S; S.A0 = (const char*)HF; S.B0 = (const char*)(wl + WL_FFO); S.nM0 = M / 256; S.nN0 = 4; S.A1 = nullptr; S.B1 = nullptr; S.nM1 = 0; S.nN1 = 0; S.np = 1; S.K = FFH; S.G = G; S.c = launder_i(blockIdx.x);
            EpiRes E{(l + 1 < DEPTH) ? nullptr : AOUT(), ws, (l + 1 < DEPTH) ? (l + 1) * 6 + SS_MIX : -1, nullptr};
#if !defined(SKIP_GEMM) && (!defined(GSEL) || (GSEL & 64))
            pg8::gemm_phase(lds, S, E, wave);
#endif
        }
        if (l + 1 < DEPTH) GSYNC();
    }
}

constexpr int LDS_BYTES = 147456;

extern "C" void kernel_launch(void* const* d_in, const int* in_sizes, int n_in, void* d_out, int out_size, void* d_ws, size_t ws_size, hipStream_t stream) {
    static int grid = 0;
    if (grid == 0) {
        int dev = 0, cus = 0, per_cu = 0;
        hipGetDevice(&dev);
        hipDeviceGetAttribute(&cus, hipDeviceAttributeMultiprocessorCount, dev);
        hipFuncSetAttribute((const void*)fwd_kernel, hipFuncAttributeMaxDynamicSharedMemorySize, LDS_BYTES);
        hipOccupancyMaxActiveBlocksPerMultiprocessor(&per_cu, (const void*)fwd_kernel, NWAVES * 64, LDS_BYTES);
        (void)hipGetLastError();
        if (per_cu < 1) per_cu = 1;
        grid = cus;
        if (grid <= 0) grid = 256;
    }
    hipMemsetAsync((char*)d_ws + WS_BAR, 0, 16384, stream);
    KArgs a{};
    for (int i = 0; i < 33; ++i) a.in[i] = (const float*)d_in[i];
    a.out = (float*)d_out; a.ws = (unsigned char*)d_ws;
    void* args[] = {&a};
    hipError_t e = hipLaunchCooperativeKernel((const void*)fwd_kernel, dim3(grid), dim3(NWAVES * 64), args, LDS_BYTES, stream);
    if (e != hipSuccess) fprintf(stderr, "cooperative launch failed: %s (grid %d)\n", hipGetErrorString(e), grid);
}
```

```cpp
#include <hip/hip_runtime.h>
#include <hip/hip_cooperative_groups.h>
#include <cstdio>
#include <cstdint>
namespace cg = cooperative_groups;

#define LAS __attribute__((address_space(3)))
typedef unsigned short bf16_t;
typedef short bf16x8 __attribute__((ext_vector_type(8)));
typedef short s16x4 __attribute__((ext_vector_type(4)));
typedef float f32x4 __attribute__((ext_vector_type(4)));
typedef float f32x2 __attribute__((ext_vector_type(2)));
typedef float f32x16 __attribute__((ext_vector_type(16)));
typedef unsigned u32x4 __attribute__((ext_vector_type(4)));
typedef unsigned u32x2 __attribute__((ext_vector_type(2)));

constexpr int BATCH = 2, SEQ = 8192, DM = 1024, M = BATCH * SEQ, DEPTH = 2;
constexpr int NIN = 2304, FFH = 2816, NMEM = 256;
constexpr float EPS = 1e-6f;
constexpr float LOG2E = 1.4426950408889634f;
constexpr int NWAVES = 8;

constexpr size_t MiB = 1u << 20;
constexpr size_t WS_SS = 0;
constexpr size_t WS_BAR = 768 * 1024;
constexpr size_t WS_W = 1 * MiB;
constexpr size_t WL_IN = 0, WL_OUT = 4718592, WL_Q = 6815744, WL_O = 8912896, WL_FFI = 11010048, WL_FFO = 22544384, WL_PW2 = 28311552, WL_GLU = 28442624, WL_STRIDE = 28704768;
constexpr size_t WS_WKV = WS_W + 2 * WL_STRIDE;
constexpr size_t WS_XB = 64 * MiB;
constexpr size_t WS_RA = 96 * MiB;
constexpr size_t WS_Q = WS_RA, WS_K = WS_RA + 16 * MiB, WS_VT = WS_RA + 32 * MiB, WS_HC = WS_RA + 48 * MiB, WS_U = WS_RA + 56 * MiB,
                 WS_AC = WS_RA + 64 * MiB, WS_YS = WS_RA + 72 * MiB, WS_KRAW = WS_RA + 80 * MiB;
constexpr size_t WS_HF = WS_RA;
constexpr size_t WS_MIX = 184 * MiB;
constexpr size_t WS_XL = 216 * MiB;
constexpr size_t WS_SSQ = 255 * MiB;
constexpr size_t WS_SST = 248 * MiB, WS_KP = 250 * MiB, WS_VTM = 252 * MiB, WS_HMN = 254 * MiB;
static_assert(WS_WKV + 2 * 2048 * 1024 * 2 <= WS_XB, "weights fit");

enum { SS_MIX = 0, SS_SB = 1, SS_CONV = 2, SS_SSM = 3, SS_XA = 4, SS_FFN = 5 };

typedef __bf16 bf16x2_t __attribute__((ext_vector_type(2)));
__device__ __forceinline__ unsigned cvt_pk_bf16(float lo, float hi) { f32x2 v = {lo, hi}; bf16x2_t b = __builtin_convertvector(v, bf16x2_t); return __builtin_bit_cast(unsigned, b); }
__device__ __forceinline__ bf16_t f2bf(float f) { unsigned u = __builtin_bit_cast(unsigned, f); return (bf16_t)((u + 0x7fffu + ((u >> 16) & 1u)) >> 16); }
__device__ __forceinline__ float bf2f(unsigned short b) { return __builtin_bit_cast(float, (unsigned)b << 16); }
__device__ __forceinline__ float bflo(unsigned w) { return __builtin_bit_cast(float, w << 16); }
__device__ __forceinline__ float bfhi(unsigned w) { return __builtin_bit_cast(float, w & 0xffff0000u); }
__device__ __forceinline__ float ex2(float x) { return __builtin_amdgcn_exp2f(x); }
__device__ __forceinline__ float lg2(float x) { return __builtin_amdgcn_logf(x); }
__device__ __forceinline__ float sigmoidf_(float x) { return __builtin_amdgcn_rcpf(1.f + ex2(-x * LOG2E)); }
__device__ __forceinline__ int crow(int r, int hi) { return (r & 3) + 8 * (r >> 2) + 4 * hi; }
template <int MASK> __device__ __forceinline__ float xshfl(float v) {
    if constexpr (MASK == 32) {
        const unsigned u = __builtin_bit_cast(unsigned, v);
        auto rr = __builtin_amdgcn_permlane32_swap(u, u, false, false);
        const bool up = (__builtin_amdgcn_mbcnt_hi(~0u, __builtin_amdgcn_mbcnt_lo(~0u, 0u)) & 32u) != 0u;
        return __builtin_bit_cast(float, up ? (unsigned)rr[0] : (unsigned)rr[1]);
    } else {
        return __builtin_bit_cast(float, __builtin_amdgcn_ds_swizzle(__builtin_bit_cast(int, v), (MASK << 10) | 0x1f));
    }
}
__device__ __forceinline__ float wave_sum(float v) {
    v += xshfl<1>(v); v += xshfl<2>(v); v += xshfl<4>(v); v += xshfl<8>(v); v += xshfl<16>(v); v += xshfl<32>(v);
    return v;
}
#define MFMA32(a, b, c) __builtin_amdgcn_mfma_f32_32x32x16_bf16((a), (b), (c), 0, 0, 0)
#define MFMA16(a, b, c) __builtin_amdgcn_mfma_f32_16x16x32_bf16((a), (b), (c), 0, 0, 0)

namespace pg8 {
constexpr int BM = 256, BK = 64, HALF = 128, HTB = HALF * BK * 2, STAGE_BYTES = 8 * HTB, NXCD = 8, WGM = 8;
__device__ __forceinline__ int lds_byte(int r, int c) { const int st = (r >> 4) * 2 + (c >> 5), rr = r & 15, cc = c & 31, ob = rr * 64 + cc * 2; return st * 1024 + (ob ^ (((ob >> 9) & 1) << 5)); }
__device__ __forceinline__ void stage_rc(int b, int& R, int& C) { const int st = b / 1024, sb = b % 1024, swz = sb ^ (((sb >> 9) & 1) << 5); R = (st >> 1) * 16 + swz / 64; C = (st & 1) * 32 + (swz % 64) / 2; }
__device__ __forceinline__ int perm32(int rho) { const int n = rho >> 4, i = rho & 15; return 8 * (i >> 2) + 4 * n + (i & 3); }

struct Unit { int pm, pn, prob; const char* a; const char* b; };
struct Sched {
    const char *A0, *A1, *B0, *B1; int nM0, nM1, nN0, nN1; int np, K, G, c;
    __device__ __forceinline__ int lda() const { return K; }
    __device__ __forceinline__ int ldb() const { return K; }
    __device__ __forceinline__ bool next(int i, Unit& u) const {
        long L = (long)i * G + c; int p = 0;
        const int n0 = nM0 * nN0;
        if (L >= n0) { if (np < 2) return false; L -= n0; p = 1; if (L >= nM1 * nN1) return false; }
        const int nm = p ? nM1 : nM0, nn = p ? nN1 : nN0, nwg = nm * nn;
        int wgid = (int)L; { const int q = nwg / NXCD, r = nwg % NXCD, xcd = wgid % NXCD, off = wgid / NXCD; wgid = (xcd < r ? xcd * (q + 1) : r * (q + 1) + (xcd - r) * q) + off; }
        const int nig = WGM * nn, gid = wgid / nig, fm = gid * WGM, gsz = (nm - fm) < WGM ? (nm - fm) : WGM;
        u.pm = fm + ((wgid % nig) % gsz); u.pn = (wgid % nig) / gsz; u.prob = p;
        const size_t tstep = (size_t)BM * K * 2;
        u.a = (p ? A1 : A0) + (size_t)u.pm * tstep; u.b = (p ? B1 : B0) + (size_t)u.pn * tstep; return true;
    }
};

struct SchedXA {
    const char* A; const char* B; int K, G, c;
    __device__ __forceinline__ int lda() const { return 1024; }
    __device__ __forceinline__ int ldb() const { return 256; }
    __device__ __forceinline__ bool next(int i, Unit& u) const {
        const long L = (long)i * G + c; if (L >= 256) return false;
        const int v = (int)L, xq = v & 7, off = v >> 3, pm = 8 * xq + (off & 7), head = off >> 3, b = pm >> 5, bh = b * 4 + head;
        u.pm = pm; u.pn = head; u.prob = 0;
        u.a = A + ((size_t)u.pm * 256 * 1024 + (size_t)head * 256) * 2; u.b = B + (size_t)bh * 256 * 256 * 2; return true;
    }
};
__device__ __forceinline__ int lane_id_asm_() { int l; asm volatile("v_mbcnt_lo_u32_b32 %0, -1, 0\n\tv_mbcnt_hi_u32_b32 %0, -1, %0" : "=v"(l)); return l; }
struct NoHook { __device__ __forceinline__ void operator()(int, f32x4 (&)[2][2][4][2], int, int) const {} };
struct HookMix {
    const LAS float* fac;
    __device__ __forceinline__ void operator()(int t, f32x4 (&acc)[2][2][4][2], int wr, int fr) const {
        if (t == 8 || t == 12) {
            const int idx = (t == 8) ? 0 : 1;
#pragma unroll
            for (int ai = 0; ai < 2; ++ai)
#pragma unroll
                for (int m = 0; m < 4; ++m) {
                    const float f = fac[(ai * 128 + wr * 64 + m * 16 + fr) * 4 + idx];
#pragma unroll
                    for (int bj = 0; bj < 2; ++bj)
#pragma unroll
                        for (int n = 0; n < 2; ++n) acc[ai][bj][m][n] *= f;
                }
        }
    }
};
template <class Epi, class SchedT, class HookT = NoHook>
__device__ __forceinline__ void gemm_phase(LAS unsigned char* lds, const SchedT& S, const Epi& E, int wave_, const HookT& H = HookT()) {
    const int tid_ = wave_ * 64 + lane_id_asm_();
    int K_ = S.K; asm volatile("" : "+s"(K_));
    const int tid = tid_, wid = __builtin_amdgcn_readfirstlane(tid >> 6), lane = tid & 63, wr = wid >> 2, wc = wid & 3, fr = lane & 15, fq = lane >> 4;
    const int K = K_, nt = K / BK;
    unsigned voffA[2], voffB[2];
#pragma unroll
    for (int i = 0; i < 2; ++i) { int R, C; stage_rc(tid * 16 + i * 8192, R, C); const int Rb = (R & ~31) + perm32(R & 31);
        voffA[i] = (unsigned)(R * S.lda() + C) * 2u; voffB[i] = (unsigned)(Rb * S.ldb() + C) * 2u; }
    const size_t kstep = (size_t)(BK * 2);
    const size_t hstepA = (size_t)HALF * S.lda() * 2, hstepB = (size_t)HALF * S.ldb() * 2;
    const unsigned ldsw = (unsigned)wid * 1024u;
    const int aoff = lds_byte(wr * 64 + fr, fq * 8), boff = lds_byte(wc * 32 + fr, fq * 8);
#define PG8_SA(b, h) (((b) * 2 + (h)) * HTB)
#define PG8_SB(b, h) ((4 + (b) * 2 + (h)) * HTB)
#define PG8_STAGE(bufoff, gbase, voff) do { _Pragma("unroll") for (int _i = 0; _i < 2; ++_i) \
        __builtin_amdgcn_global_load_lds((const unsigned*)((const char*)(gbase) + (voff)[_i]), (LAS unsigned*)(lds + (bufoff) + ldsw + _i * 8192), 16, 0, 0); } while (0)
#define PG8_LDA(dst, b, h) do { _Pragma("unroll") for (int m = 0; m < 4; ++m) _Pragma("unroll") for (int k = 0; k < 2; ++k) dst[m][k] = *(const LAS bf16x8*)(lds + PG8_SA(b, h) + aoff + m * 2048 + k * 1024); } while (0)
#define PG8_LDB(dst, b, h) do { _Pragma("unroll") for (int n = 0; n < 2; ++n) _Pragma("unroll") for (int k = 0; k < 2; ++k) dst[n][k] = *(const LAS bf16x8*)(lds + PG8_SB(b, h) + boff + n * 2048 + k * 1024); } while (0)
#define PG8_MMA(ai, bj, At, Bt) do { __builtin_amdgcn_s_setprio(1); _Pragma("unroll") for (int m = 0; m < 4; ++m) _Pragma("unroll") for (int n = 0; n < 2; ++n) _Pragma("unroll") for (int k = 0; k < 2; ++k) \
        acc[ai][bj][m][n] = __builtin_amdgcn_mfma_f32_16x16x32_bf16(Bt[n][k], At[m][k], acc[ai][bj][m][n], 0, 0, 0); __builtin_amdgcn_s_setprio(0); } while (0)
#define PG8_WAIT_V(n) asm volatile("s_waitcnt vmcnt(" #n ")" ::: "memory")
#define PG8_WAIT_L(n) asm volatile("s_waitcnt lgkmcnt(" #n ")" ::: "memory")
#define PG8_BAR __builtin_amdgcn_s_barrier()
#define PG8_SCHED __builtin_amdgcn_sched_barrier(0)
    Unit cur, nxt; int ui = 0;
    if (!S.next(0, cur)) return;
    f32x4 acc[2][2][4][2];
#pragma unroll
    for (int a = 0; a < 2; ++a)
#pragma unroll
        for (int b = 0; b < 2; ++b)
#pragma unroll
            for (int m = 0; m < 4; ++m)
#pragma unroll
                for (int n = 0; n < 2; ++n) acc[a][b][m][n] = (f32x4){0.f, 0.f, 0.f, 0.f};
    bf16x8 At[4][2], B0[2][2], B1[2][2];
    const char* cA = cur.a; const char* cB = cur.b;
    PG8_STAGE(PG8_SB(0, 0), cB, voffB); PG8_STAGE(PG8_SB(0, 1), cB + hstepB, voffB); PG8_STAGE(PG8_SA(0, 0), cA, voffA); PG8_STAGE(PG8_SA(0, 1), cA + hstepA, voffA);
    if (wr == 1) PG8_BAR;
    PG8_WAIT_V(2); PG8_BAR;
    PG8_STAGE(PG8_SB(1, 0), cB + kstep, voffB); PG8_STAGE(PG8_SA(1, 0), cA + kstep, voffA); PG8_STAGE(PG8_SB(1, 1), cB + hstepB + kstep, voffB);
    PG8_WAIT_V(6); PG8_BAR;
    for (;;) {
        const bool has_next = S.next(ui + 1, nxt);
        const char* nA = has_next ? nxt.a : cA; const char* nB = has_next ? nxt.b : cB;
        for (int t = 0; t < nt; t += 2) {
            H(t, acc, wr, fr);
            const bool last = (t == nt - 2);
            const char* a1 = cA + (size_t)(t + 1) * kstep;
            const char* a2 = last ? nA : cA + (size_t)(t + 2) * kstep; const char* b2 = last ? nB : cB + (size_t)(t + 2) * kstep;
            const char* a3 = a2 + kstep; const char* b3 = b2 + kstep;
            PG8_LDB(B0, 0, 0); PG8_LDB(B1, 0, 1); PG8_SCHED; PG8_LDA(At, 0, 0); PG8_STAGE(PG8_SA(1, 1), a1 + hstepA, voffA);
            PG8_WAIT_V(8); PG8_WAIT_L(0); PG8_BAR; PG8_MMA(0, 0, At, B0); PG8_MMA(0, 1, At, B1); PG8_BAR; PG8_SCHED;
            PG8_LDA(At, 0, 1); PG8_STAGE(PG8_SB(0, 0), b2, voffB); PG8_STAGE(PG8_SB(0, 1), b2 + hstepB, voffB); PG8_STAGE(PG8_SA(0, 0), a2, voffA);
            PG8_WAIT_V(8); PG8_WAIT_L(0); PG8_BAR; PG8_MMA(1, 0, At, B0); PG8_MMA(1, 1, At, B1); PG8_BAR; PG8_SCHED;
            PG8_LDB(B0, 1, 0); PG8_LDB(B1, 1, 1); PG8_SCHED; PG8_LDA(At, 1, 0); PG8_STAGE(PG8_SA(0, 1), a2 + hstepA, voffA);
            PG8_WAIT_V(8); PG8_WAIT_L(0); PG8_BAR; PG8_MMA(0, 0, At, B0); PG8_MMA(0, 1, At, B1); PG8_BAR; PG8_SCHED;
            PG8_LDA(At, 1, 1); PG8_STAGE(PG8_SB(1, 0), b3, voffB); PG8_STAGE(PG8_SB(1, 1), b3 + hstepB, voffB); PG8_STAGE(PG8_SA(1, 0), a3, voffA);
            PG8_WAIT_V(8); PG8_WAIT_L(0); PG8_BAR; PG8_MMA(1, 0, At, B0); PG8_MMA(1, 1, At, B1); PG8_BAR; PG8_SCHED;
        }
        if (wr == 0) PG8_BAR;
        E(acc, cur, wr, wc, fr, fq);
        if (!has_next) break;
#pragma unroll
        for (int a = 0; a < 2; ++a)
#pragma unroll
            for (int b = 0; b < 2; ++b)
#pragma unroll
                for (int m = 0; m < 4; ++m)
#pragma unroll
                    for (int n = 0; n < 2; ++n) acc[a][b][m][n] = (f32x4){0.f, 0.f, 0.f, 0.f};
        cur = nxt; cA = nA; cB = nB; ++ui;
        if (wr == 1) PG8_BAR;
    }
    PG8_WAIT_V(0);
    PG8_BAR;
#undef PG8_SA
#undef PG8_SB
#undef PG8_STAGE
#undef PG8_LDA
#undef PG8_LDB
#undef PG8_MMA
#undef PG8_WAIT_V
#undef PG8_WAIT_L
#undef PG8_BAR
#undef PG8_SCHED
}
}
using pg8::Unit;
#define GASP __attribute__((address_space(1)))
__device__ __forceinline__ unsigned char* launder(unsigned char* p) { unsigned long long v = (unsigned long long)p; asm volatile("" : "+s"(v)); return (unsigned char*)(GASP unsigned char*)v; }
__device__ __forceinline__ int lane_id_asm() { int l; asm volatile("v_mbcnt_lo_u32_b32 %0, -1, 0\n\tv_mbcnt_hi_u32_b32 %0, -1, %0" : "=v"(l)); return l; }
__device__ __forceinline__ int launder_i(int v) { asm volatile("" : "+s"(v)); return v; }
#define SSP(l, k) ((float*)(ws + WS_SS) + (size_t)((l) * 6 + (k)) * M)
typedef f32x4 Acc[2][2][4][2];

__device__ __forceinline__ void st16(bf16_t* p, const float* v) {
    u32x4 w; w.x = cvt_pk_bf16(v[0], v[1]); w.y = cvt_pk_bf16(v[2], v[3]); w.z = cvt_pk_bf16(v[4], v[5]); w.w = cvt_pk_bf16(v[6], v[7]);
    *(u32x4*)p = w;
}

__device__ __forceinline__ void load_rs(float (&rs)[2][4], const float* ssx, int row0) {
#pragma unroll
    for (int ai = 0; ai < 2; ++ai)
#pragma unroll
        for (int m = 0; m < 4; ++m) rs[ai][m] = ssx[row0 + ai * 128 + m * 16];
#pragma unroll
    for (int ai = 0; ai < 2; ++ai)
#pragma unroll
        for (int m = 0; m < 4; ++m) rs[ai][m] = __builtin_amdgcn_rsqf(rs[ai][m] * (1.f / 1024.f) + EPS);
}
__device__ __forceinline__ void st16_nt(bf16_t* p, const float* v) {
    u32x4 w; w.x = cvt_pk_bf16(v[0], v[1]); w.y = cvt_pk_bf16(v[2], v[3]); w.z = cvt_pk_bf16(v[4], v[5]); w.w = cvt_pk_bf16(v[6], v[7]);
    __builtin_nontemporal_store(w, (u32x4*)p);
}
struct EpiIn {
    unsigned char* ws_; int l; const float* qg; const float* kg;
    __device__ __forceinline__ void operator()(const Acc& acc, const Unit& u, int wr, int wc, int fr, int fq) const {
        unsigned char* ws = launder(ws_);
        const float* ssx = SSP(l, SS_MIX);
        bf16_t* Q = (bf16_t*)(ws + WS_Q); bf16_t* Kb = (bf16_t*)(ws + WS_K); bf16_t* Vt = (bf16_t*)(ws + WS_VT); bf16_t* HC = (bf16_t*)(ws + WS_HC); bf16_t* U = (bf16_t*)(ws + WS_U);
        float* kraw = (float*)(ws + WS_KRAW); bf16_t* vtm = (bf16_t*)(ws + WS_VTM);
        if (u.prob == 0) {
            const int pn = u.pn;
            float rsv[2][4]; load_rs(rsv, ssx, u.pm * 256 + wr * 64 + fr);
            if (pn < 4) {
                const float* g = (pn < 2) ? qg : kg; bf16_t* dst = (pn < 2) ? Q : Kb;
                const float post = (pn < 2) ? 0.125f * LOG2E : 1.0f;
                const int head = 4 * (pn & 1) + wc;
#pragma unroll
                for (int ai = 0; ai < 2; ++ai)
#pragma unroll
                    for (int m = 0; m < 4; ++m) {
                        const int row = u.pm * 256 + ai * 128 + wr * 64 + m * 16 + fr;
                        const float rs = rsv[ai][m];
                        f32x4 v[2][2]; float ss = 0.f;
#pragma unroll
                        for (int bj = 0; bj < 2; ++bj)
#pragma unroll
                            for (int n = 0; n < 2; ++n) { v[bj][n] = acc[ai][bj][m][n] * rs; const f32x4 x = v[bj][n]; ss += (x[0] * x[0] + x[1] * x[1]) + (x[2] * x[2] + x[3] * x[3]); }
                        ss += xshfl<16>(ss); ss += xshfl<32>(ss);
                        const float hn = __builtin_amdgcn_rsqf(ss * (1.f / 64.f) + EPS) * post;
#pragma unroll
                        for (int bj = 0; bj < 2; ++bj) {
                            float o[8];
#pragma unroll
                            for (int n = 0; n < 2; ++n) { const f32x4 gv = *(const f32x4*)(g + 32 * bj + 8 * fq + 4 * n);
#pragma unroll
                                for (int j = 0; j < 4; ++j) o[4 * n + j] = v[bj][n][j] * hn * gv[j]; }
                            st16(dst + (size_t)row * 512 + head * 64 + 32 * bj + 8 * fq, o);
                        }
                        asm volatile("" ::: "memory");
                    }
            } else if (pn < 6) {
#pragma unroll
                for (int ai = 0; ai < 2; ++ai)
#pragma unroll
                    for (int m = 0; m < 4; ++m) {
                        const int row = u.pm * 256 + ai * 128 + wr * 64 + m * 16 + fr;
                        const float rs = rsv[ai][m];
                        const int b = row >> 13, t = row & (SEQ - 1);
#pragma unroll
                        for (int bj = 0; bj < 2; ++bj) {
                            const int h = 4 * (pn - 4) + 2 * bj + (wc >> 1);
#pragma unroll
                            for (int n = 0; n < 2; ++n)
#pragma unroll
                                for (int j = 0; j < 4; ++j) {
                                    const int d = 32 * (wc & 1) + 8 * fq + 4 * n + j;
                                    Vt[((size_t)(b * 8 + h) * 64 + d) * SEQ + t] = f2bf(acc[ai][bj][m][n][j] * rs);
                                }
                        }
                    }
            } else if (pn < 8) {
#pragma unroll
                for (int ai = 0; ai < 2; ++ai)
#pragma unroll
                    for (int m = 0; m < 4; ++m) {
                        const int row = u.pm * 256 + ai * 128 + wr * 64 + m * 16 + fr;
                        const float rs = rsv[ai][m];
                        float o[8];
#pragma unroll
                        for (int n = 0; n < 2; ++n)
#pragma unroll
                            for (int j = 0; j < 4; ++j) { const float a = acc[ai][0][m][n][j] * rs, b = acc[ai][1][m][n][j] * rs; o[4 * n + j] = a * sigmoidf_(b); }
                        st16(HC + (size_t)row * 256 + 128 * (pn - 6) + 32 * wc + 8 * fq, o);
                    }
            } else {
#pragma unroll
                for (int ai = 0; ai < 2; ++ai)
#pragma unroll
                    for (int m = 0; m < 4; ++m) {
                        const int row = u.pm * 256 + ai * 128 + wr * 64 + m * 16 + fr;
                        const float rs = rsv[ai][m];
#pragma unroll
                        for (int bj = 0; bj < 2; ++bj) {
                            float o[8];
#pragma unroll
                            for (int n = 0; n < 2; ++n)
#pragma unroll
                                for (int j = 0; j < 4; ++j) o[4 * n + j] = acc[ai][bj][m][n][j] * rs;
                            st16(U + (size_t)row * 256 + 128 * bj + 32 * wc + 8 * fq, o);
                        }
                    }
            }
        } else {
            const int lay = u.pn >> 3, sub = u.pn & 7;
#pragma unroll
            for (int ai = 0; ai < 2; ++ai)
#pragma unroll
                for (int m = 0; m < 4; ++m) {
                    const int row = u.pm * 256 + ai * 128 + wr * 64 + m * 16 + fr;
                    if (sub < 4) {
#pragma unroll
                        for (int bj = 0; bj < 2; ++bj)
#pragma unroll
                            for (int n = 0; n < 2; ++n)
                                *(f32x4*)(kraw + ((size_t)lay * 512 + row) * 1024 + sub * 256 + 128 * bj + 32 * wc + 8 * fq + 4 * n) = acc[ai][bj][m][n];
                    } else {
                        const int b = row >> 8, mt = row & 255, head = sub - 4;
#pragma unroll
                        for (int bj = 0; bj < 2; ++bj)
#pragma unroll
                            for (int n = 0; n < 2; ++n)
#pragma unroll
                                for (int j = 0; j < 4; ++j) {
                                    const int d = 128 * bj + 32 * wc + 8 * fq + 4 * n + j;
                                    vtm[((size_t)((lay * 2 + b) * 4 + head) * 256 + d) * 256 + mt] = f2bf(acc[ai][bj][m][n][j]);
                                }
                    }
                }
        }
    }
};

struct EpiPwGlu {
    unsigned char* ws_; int l;
    __device__ __forceinline__ void operator()(const Acc& acc, const Unit& u, int wr, int wc, int fr, int fq) const {
        unsigned char* ws = launder(ws_);
        bf16_t* MIX = (bf16_t*)(ws + WS_MIX); float* ss_conv = SSP(l, SS_CONV);
#pragma unroll
        for (int ai = 0; ai < 2; ++ai)
#pragma unroll
            for (int m = 0; m < 4; ++m) {
                const int row = u.pm * 256 + ai * 128 + wr * 64 + m * 16 + fr;
                float ss = 0.f;
                if (u.prob == 0) {
#pragma unroll
                    for (int bj = 0; bj < 2; ++bj) {
                        float o[8];
#pragma unroll
                        for (int n = 0; n < 2; ++n)
#pragma unroll
                            for (int j = 0; j < 4; ++j) { o[4 * n + j] = acc[ai][bj][m][n][j]; ss += o[4 * n + j] * o[4 * n + j]; }
                        st16(MIX + (size_t)row * 1024 + 512 + 128 * bj + 32 * wc + 8 * fq, o);
                    }
                } else {
                    float o[8];
#pragma unroll
                    for (int n = 0; n < 2; ++n)
#pragma unroll
                        for (int j = 0; j < 4; ++j) { const float v = acc[ai][0][m][n][j] * sigmoidf_(acc[ai][1][m][n][j]); o[4 * n + j] = v; ss += v * v; }
                    st16(MIX + (size_t)row * 1024 + 768 + 128 * u.pn + 32 * wc + 8 * fq, o);
                }
                ss += xshfl<16>(ss); ss += xshfl<32>(ss);
                if (fq == 0) atomicAdd(ss_conv + (size_t)u.prob * M + row, ss);
            }
    }
};

struct EpiRes {
    float* xfinal; unsigned char* ws_; int ssidx;
    const LAS float* fac;
    __device__ __forceinline__ void operator()(const Acc& acc, const Unit& u, int wr, int wc, int fr, int fq) const {
        unsigned char* ws = launder(ws_);
        bf16_t* XB = (bf16_t*)(ws + WS_XB); float* ssn = ssidx >= 0 ? (float*)(ws + WS_SS) + (size_t)ssidx * M : nullptr;
#pragma unroll
        for (int ai = 0; ai < 2; ++ai) {
            u32x4 xh[4][2];
#pragma unroll
            for (int m = 0; m < 4; ++m) {
                const size_t off = (size_t)(u.pm * 256 + ai * 128 + wr * 64 + m * 16 + fr) * 1024 + u.pn * 256 + 32 * wc + 8 * fq;
#pragma unroll
                for (int bj = 0; bj < 2; ++bj) xh[m][bj] = *(const u32x4*)(XB + off + 128 * bj);
            }
#pragma unroll
            for (int m = 0; m < 4; ++m) {
                const int row = u.pm * 256 + ai * 128 + wr * 64 + m * 16 + fr;
                const float f3 = fac ? fac[(ai * 128 + wr * 64 + m * 16 + fr) * 4 + 2] : 1.f;
                float ss = 0.f;
#pragma unroll
                for (int bj = 0; bj < 2; ++bj) {
                    const size_t off = (size_t)row * 1024 + u.pn * 256 + 128 * bj + 32 * wc + 8 * fq;
                    float o[8];
#pragma unroll
                    for (int n = 0; n < 2; ++n)
#pragma unroll
                        for (int j = 0; j < 4; ++j) {
                            const int e = 4 * n + j; const unsigned wh = xh[m][bj][e >> 1];
                            const float v = ((e & 1) ? bfhi(wh) : bflo(wh)) + acc[ai][bj][m][n][j] * f3;
                            o[e] = v; ss += v * v;
                        }
                    if (xfinal) { *(f32x4*)(xfinal + off) = (f32x4){o[0], o[1], o[2], o[3]}; *(f32x4*)(xfinal + off + 4) = (f32x4){o[4], o[5], o[6], o[7]}; }
                    else st16(XB + off, o);
                }
                if (ssn) { ss += xshfl<16>(ss); ss += xshfl<32>(ss); if (fq == 0) atomicAdd(ssn + row, ss); }
            }
            asm volatile("" ::: "memory");
        }
    }
};

struct EpiQ {
    unsigned char* ws_; int l;
    __device__ __forceinline__ void operator()(const Acc& acc, const Unit& u, int wr, int wc, int fr, int fq) const {
        unsigned char* ws = launder(ws_);
        const float* ssx = SSP(l, SS_XA); bf16_t* XQ = (bf16_t*)(ws + WS_MIX);
        float rsv[2][4]; load_rs(rsv, ssx, u.pm * 256 + wr * 64 + fr);
#pragma unroll
        for (int ai = 0; ai < 2; ++ai)
#pragma unroll
            for (int m = 0; m < 4; ++m) {
                const int row = u.pm * 256 + ai * 128 + wr * 64 + m * 16 + fr;
                const float rs = rsv[ai][m];
                float ss = 0.f;
#pragma unroll
                for (int bj = 0; bj < 2; ++bj) {
                    float o[8];
#pragma unroll
                    for (int n = 0; n < 2; ++n)
#pragma unroll
                        for (int j = 0; j < 4; ++j) { o[4 * n + j] = acc[ai][bj][m][n][j] * rs; ss += o[4 * n + j] * o[4 * n + j]; }
                    st16(XQ + (size_t)row * 1024 + u.pn * 256 + 128 * bj + 32 * wc + 8 * fq, o);
                }
                ss += xshfl<16>(ss); ss += xshfl<32>(ss);
                if (fq == 0) atomicAdd((float*)(ws + WS_SSQ) + (size_t)(l * 4 + u.pn) * M + row, ss);
                asm volatile("" ::: "memory");
            }
    }
};

struct EpiFfn {
    unsigned char* ws_; int l;
    __device__ __forceinline__ void operator()(const Acc& acc, const Unit& u, int wr, int wc, int fr, int fq) const {
        unsigned char* ws = launder(ws_);
        const float* ssx = SSP(l, SS_FFN); bf16_t* HF = (bf16_t*)(ws + WS_HF);
        float rsv[2][4]; load_rs(rsv, ssx, u.pm * 256 + wr * 64 + fr);
#pragma unroll
        for (int ai = 0; ai < 2; ++ai)
#pragma unroll
            for (int m = 0; m < 4; ++m) {
                const int row = u.pm * 256 + ai * 128 + wr * 64 + m * 16 + fr;
                const float rs = rsv[ai][m];
                float o[8];
#pragma unroll
                for (int n = 0; n < 2; ++n)
#pragma unroll
                    for (int j = 0; j < 4; ++j) { const float g = acc[ai][0][m][n][j] * rs, up = acc[ai][1][m][n][j] * rs; o[4 * n + j] = g * sigmoidf_(g) * up; }
                st16_nt(HF + (size_t)row * FFH + 128 * u.pn + 32 * wc + 8 * fq, o);
            }
    }
};

constexpr int EX_OFF = 131072 + 4096;
struct EpiSm {
    unsigned char* ws_; int l; LAS unsigned char* lds;
    __device__ __forceinline__ void operator()(const Acc& acc, const Unit& u, int wr, int wc, int fr, int fq) const {
        unsigned char* ws = launder(ws_);
        const float* ssq = (const float*)(ws + WS_SSQ) + (size_t)(l * 4 + u.pn) * M;
        bf16_t* P = (bf16_t*)(ws + WS_HF);
        LAS float* EXm = (LAS float*)(lds + EX_OFF); LAS float* EXs = EXm + 1024;
        float rq[2][4], mx[2][4];
#pragma unroll
        for (int ai = 0; ai < 2; ++ai)
#pragma unroll
            for (int m = 0; m < 4; ++m) {
                const int rl = ai * 128 + wr * 64 + m * 16 + fr;
                rq[ai][m] = __builtin_amdgcn_rsqf(ssq[u.pm * 256 + rl] * (1.f / 256.f) + EPS) * (0.0625f * LOG2E);
                float v = -3.0e38f;
#pragma unroll
                for (int bj = 0; bj < 2; ++bj)
#pragma unroll
                    for (int n = 0; n < 2; ++n)
#pragma unroll
                        for (int j = 0; j < 4; ++j) v = fmaxf(v, acc[ai][bj][m][n][j]);
                v *= rq[ai][m];
                v = fmaxf(v, xshfl<16>(v)); v = fmaxf(v, xshfl<32>(v));
                if (fq == 0) EXm[rl * 4 + wc] = v;
            }
        asm volatile("s_waitcnt lgkmcnt(0)" ::: "memory"); __builtin_amdgcn_s_barrier(); asm volatile("" ::: "memory");
#pragma unroll
        for (int ai = 0; ai < 2; ++ai)
#pragma unroll
            for (int m = 0; m < 4; ++m) {
                const int rl = ai * 128 + wr * 64 + m * 16 + fr;
                const f32x4 e = *(const LAS f32x4*)(EXm + rl * 4);
                mx[ai][m] = fmaxf(fmaxf(e[0], e[1]), fmaxf(e[2], e[3]));
                float s = 0.f;
#pragma unroll
                for (int bj = 0; bj < 2; ++bj)
#pragma unroll
                    for (int n = 0; n < 2; ++n)
#pragma unroll
                        for (int j = 0; j < 4; ++j) s += ex2(acc[ai][bj][m][n][j] * rq[ai][m] - mx[ai][m]);
                s += xshfl<16>(s); s += xshfl<32>(s);
                if (fq == 0) EXs[rl * 4 + wc] = s;
            }
        asm volatile("s_waitcnt lgkmcnt(0)" ::: "memory"); __builtin_amdgcn_s_barrier(); asm volatile("" ::: "memory");
#pragma unroll
        for (int ai = 0; ai < 2; ++ai)
#pragma unroll
            for (int m = 0; m < 4; ++m) {
                const int rl = ai * 128 + wr * 64 + m * 16 + fr;
                const f32x4 e = *(const LAS f32x4*)(EXs + rl * 4);
                const float inv = __builtin_amdgcn_rcpf((e[0] + e[1]) + (e[2] + e[3]));
#pragma unroll
                for (int bj = 0; bj < 2; ++bj) {
                    float o[8];
#pragma unroll
                    for (int n = 0; n < 2; ++n)
#pragma unroll
                        for (int j = 0; j < 4; ++j) o[4 * n + j] = ex2(acc[ai][bj][m][n][j] * rq[ai][m] - mx[ai][m]) * inv;
                    st16(P + (size_t)(u.pm * 256 + rl) * 1024 + u.pn * 256 + 128 * bj + 32 * wc + 8 * fq, o);
                }
            }
    }
};
struct EpiPlain {
    unsigned char* ws_; size_t off;
    __device__ __forceinline__ void operator()(const Acc& acc, const Unit& u, int wr, int wc, int fr, int fq) const {
        bf16_t* O = (bf16_t*)(launder(ws_) + off);
#pragma unroll
        for (int ai = 0; ai < 2; ++ai)
#pragma unroll
            for (int m = 0; m < 4; ++m) {
                const int row = u.pm * 256 + ai * 128 + wr * 64 + m * 16 + fr;
#pragma unroll
                for (int bj = 0; bj < 2; ++bj) {
                    float o[8];
#pragma unroll
                    for (int n = 0; n < 2; ++n)
#pragma unroll
                        for (int j = 0; j < 4; ++j) o[4 * n + j] = acc[ai][bj][m][n][j];
                    st16(O + (size_t)row * 1024 + u.pn * 256 + 128 * bj + 32 * wc + 8 * fq, o);
                }
            }
    }
};

constexpr int XBST_OFF = 131072 + 512;
constexpr int ARGS_OFF = 131072 + 1024;
__device__ __forceinline__ unsigned char* argp(LAS unsigned char* lds, int i) {
    unsigned addr = (unsigned)(uintptr_t)(lds + ARGS_OFF) + 8u * (unsigned)i; asm volatile("" : "+s"(addr));
    const unsigned long long v = *(volatile LAS unsigned long long*)(uintptr_t)addr;
    const unsigned lo = __builtin_amdgcn_readfirstlane((unsigned)v), hi = __builtin_amdgcn_readfirstlane((unsigned)(v >> 32));
    return (unsigned char*)(GASP unsigned char*)(((unsigned long long)hi << 32) | lo);
}
#define AIN(k) ((const float*)argp(lds, (k)))
#define AOUT() ((float*)argp(lds, 33))

__device__ __forceinline__ void transpose_item(const float* W, int K, int Nsrc, bf16_t* WT, int dst_row0, int src_col0, int k0, const float* gain, LAS float* scr, int lane) {
    float wv[32];
#pragma unroll
    for (int i = 0; i < 32; ++i) wv[i] = W[(size_t)(k0 + 2 * i + (lane >> 5)) * Nsrc + src_col0 + (lane & 31)];
    if (gain) {
#pragma unroll
        for (int i = 0; i < 32; ++i) wv[i] *= gain[k0 + 2 * i + (lane >> 5)];
    }
#pragma unroll
    for (int i = 0; i < 32; ++i) scr[(2 * i + (lane >> 5)) * 33 + (lane & 31)] = wv[i];
    asm volatile("s_waitcnt lgkmcnt(0)" ::: "memory");
    const int c = lane & 7;
#pragma unroll
    for (int j = 0; j < 4; ++j) { const int n = (lane >> 3) + 8 * j; const LAS float* s = scr + (8 * c) * 33 + n;
        u32x4 o; o.x = cvt_pk_bf16(s[0 * 33], s[1 * 33]); o.y = cvt_pk_bf16(s[2 * 33], s[3 * 33]); o.z = cvt_pk_bf16(s[4 * 33], s[5 * 33]); o.w = cvt_pk_bf16(s[6 * 33], s[7 * 33]);
        *(u32x4*)(WT + (size_t)(dst_row0 + n) * K + k0 + 8 * c) = o; }
    asm volatile("s_waitcnt lgkmcnt(0)" ::: "memory");
}
__device__ __forceinline__ int colmap_in(int c) { const int pn = c >> 8, bj = (c >> 7) & 1, wc = (c >> 5) & 3;
    if (pn < 4) return 256 * pn + 64 * wc + 32 * bj;
    if (pn == 6 || pn == 7) return 1536 + 256 * bj + 128 * (pn - 6) + 32 * wc;
    return c; }
__device__ __forceinline__ int colmap_ffn(int c) { const int pn = c >> 8, bj = (c >> 7) & 1, wc = (c >> 5) & 3; return FFH * bj + 128 * pn + 32 * wc; }
__device__ __forceinline__ int colmap_glu(int c) { const int pn = c >> 8, bj = (c >> 7) & 1, wc = (c >> 5) & 3; return 256 * bj + 128 * pn + 32 * wc; }

struct KArgs { const float* in[33]; float* out; unsigned char* ws; };

__device__ __forceinline__ void transpose_job(int it, const float* W, int K, int Nsrc, int Ndst, bf16_t* WT, int dst_row_off, const float* gain, int mode, LAS float* scr, int lane) {
    const int nblk = Ndst / 32, kb = it / nblk, nb = it % nblk, n0 = 32 * nb;
    const int src = mode == 1 ? colmap_in(n0) : mode == 2 ? colmap_ffn(n0) : mode == 3 ? colmap_glu(n0) : n0;
    transpose_item(W, K, Nsrc, WT, dst_row_off + n0, src, 64 * kb, gain, scr, lane);
}

constexpr int CI_IN = (DM / 64) * (NIN / 32), CI_SQ = (DM / 64) * (DM / 32), CI_FFI = (DM / 64) * (2 * FFH / 32), CI_FFO = (FFH / 64) * (DM / 32), CI_PW2 = (256 / 64) * (256 / 32), CI_GLU = (256 / 64) * (512 / 32);
constexpr int CI_KV0 = CI_IN + 3 * CI_SQ, CI_KV1 = CI_IN + 5 * CI_SQ;
constexpr int CI_NIT = CI_IN + 5 * CI_SQ + CI_FFI + CI_FFO + CI_PW2 + CI_GLU, CI_DEFER = CI_NIT - 2 * CI_SQ;
__device__ __forceinline__ void convert_item(LAS unsigned char* lds, unsigned char* ws, int l, int it, LAS float* scr, int lane) {
    unsigned char* wl = ws + WS_W + (size_t)l * WL_STRIDE;
    int r = it;
    if (r < CI_IN) { transpose_job(r, AIN(3) + (size_t)l * DM * NIN, DM, NIN, NIN, (bf16_t*)(wl + WL_IN), 0, AIN(2) + l * DM, 1, scr, lane); return; } r -= CI_IN;
    if (r < CI_SQ) { transpose_job(r, AIN(21) + (size_t)l * DM * DM, DM, DM, DM, (bf16_t*)(wl + WL_OUT), 0, AIN(20) + l * DM, 0, scr, lane); return; } r -= CI_SQ;
    if (r < CI_SQ) { transpose_job(r, AIN(24) + (size_t)l * DM * DM, DM, DM, DM, (bf16_t*)(wl + WL_Q), 0, AIN(22) + l * DM, 0, scr, lane); return; } r -= CI_SQ;
    if (r < CI_SQ) { transpose_job(r, AIN(29) + (size_t)l * DM * DM, DM, DM, DM, (bf16_t*)(wl + WL_O), 0, nullptr, 0, scr, lane); return; } r -= CI_SQ;
    if (r < CI_SQ) { transpose_job(r, AIN(25) + (size_t)l * DM * DM, DM, DM, DM, (bf16_t*)(ws + WS_WKV) + (size_t)l * 2048 * 1024, 0, AIN(23) + l * DM, 0, scr, lane); return; } r -= CI_SQ;
    if (r < CI_SQ) { transpose_job(r, AIN(26) + (size_t)l * DM * DM, DM, DM, DM, (bf16_t*)(ws + WS_WKV) + (size_t)l * 2048 * 1024, 1024, AIN(23) + l * DM, 0, scr, lane); return; } r -= CI_SQ;
    if (r < CI_FFI) { transpose_job(r, AIN(31) + (size_t)l * DM * 2 * FFH, DM, 2 * FFH, 2 * FFH, (bf16_t*)(wl + WL_FFI), 0, AIN(30) + l * DM, 2, scr, lane); return; } r -= CI_FFI;
    if (r < CI_FFO) { transpose_job(r, AIN(32) + (size_t)l * FFH * DM, FFH, DM, DM, (bf16_t*)(wl + WL_FFO), 0, nullptr, 0, scr, lane); return; } r -= CI_FFO;
    if (r < CI_PW2) { transpose_job(r, AIN(10) + (size_t)l * 256 * 256, 256, 256, 256, (bf16_t*)(wl + WL_PW2), 0, nullptr, 0, scr, lane); return; } r -= CI_PW2;
    transpose_job(r, AIN(19) + (size_t)l * 256 * 512, 256, 512, 512, (bf16_t*)(wl + WL_GLU), 0, nullptr, 3, scr, lane);
}
constexpr int CI_DA = 3 * CI_SQ, CI_DB = CI_DA + CI_PW2 + CI_GLU, CI_D0 = CI_DB + CI_FFI + CI_FFO, CI_DTOT = CI_D0 + CI_DEFER, CI_DSPLIT = 7224;
static_assert(CI_DSPLIT >= CI_D0, "layer 0's own weights are converted before its later phases");
__device__ __forceinline__ void convert_deferred(LAS unsigned char* lds, unsigned char* ws, int d, LAS float* scr, int lane) {
    if (d < CI_DA) convert_item(lds, ws, 0, CI_IN + d, scr, lane);
    else if (d < CI_DB) convert_item(lds, ws, 0, (CI_NIT - CI_PW2 - CI_GLU) + (d - CI_DA), scr, lane);
    else if (d < CI_D0) convert_item(lds, ws, 0, CI_KV1 + (d - CI_DB), scr, lane);
    else { const int it = d - CI_D0; convert_item(lds, ws, 1, it < CI_KV0 ? it : it + 2 * CI_SQ, scr, lane); }
}
__device__ __forceinline__ void prologue(const KArgs& a, LAS unsigned char* lds, int gw, int NGW, int wave, int lane) {
    unsigned char* ws = a.ws;
    LAS float* scr = (LAS float*)(lds + wave * 16384);
    { float* ss = (float*)(ws + WS_SS); for (int i = gw * 64 + lane; i < 11 * M; i += NGW * 64) ss[M + i] = 0.f; }
    { float* sq = (float*)(ws + WS_SSQ); for (int i = gw * 64 + lane; i < 8 * M; i += NGW * 64) sq[i] = 0.f; }
    for (int it = gw; it < CI_IN + 4 * CI_SQ; it += NGW) {
        if (it < CI_IN) convert_item(lds, ws, 0, it, scr, lane);
        else if (it < CI_IN + 2 * CI_SQ) convert_item(lds, ws, 0, CI_KV0 + (it - CI_IN), scr, lane);
        else convert_item(lds, ws, 1, CI_KV0 + (it - CI_IN - 2 * CI_SQ), scr, lane);
    }
    for (int r = gw; r < M + BATCH * NMEM; r += NGW) {
        const bool isx = r < M;
        const float* src = isx ? a.in[0] + (size_t)r * DM : a.in[1] + (size_t)(r - M) * DM;
        f32x4 v[4]; float s = 0.f;
#pragma unroll
        for (int j = 0; j < 4; ++j) { v[j] = *(const f32x4*)(src + 256 * j + 4 * lane); s += (v[j].x * v[j].x + v[j].y * v[j].y) + (v[j].z * v[j].z + v[j].w * v[j].w); }
        s = wave_sum(s);
        float sc = 1.f; bf16_t* dst;
        if (isx) { if (lane == 0) ((float*)(ws + WS_SS))[r] = s; dst = (bf16_t*)(ws + WS_XB) + (size_t)r * DM; }
        else { sc = __builtin_amdgcn_rsqf(s * (1.f / 1024.f) + EPS); dst = (bf16_t*)(ws + WS_HMN) + (size_t)(r - M) * DM; }
#pragma unroll
        for (int j = 0; j < 4; ++j) { u32x2 w; w.x = cvt_pk_bf16(v[j].x * sc, v[j].y * sc); w.y = cvt_pk_bf16(v[j].z * sc, v[j].w * sc); *(u32x2*)(dst + 256 * j + 4 * lane) = w; }
    }
}

__device__ __forceinline__ void sb_task(int task, const bf16_t* Q, const bf16_t* Kb, const bf16_t* Vt, bf16_t* MIX, float* ss_sb, int lane, bool do_atomic = true) {
    const int r32 = lane & 31, hi = lane >> 5;
    const int qb = task & 255, h = (task >> 8) & 7, b = task >> 11;
    const size_t rowbase = (size_t)b * SEQ; const int q0 = qb * 32;
    bf16x8 qf[4];
    { const bf16_t* qp = Q + (rowbase + q0 + r32) * 512 + h * 64 + hi * 8;
#pragma unroll
      for (int ks = 0; ks < 4; ++ks) qf[ks] = *(const bf16x8*)(qp + ks * 16); }
    f32x16 o0, o1;
#pragma unroll
    for (int r = 0; r < 16; ++r) { o0[r] = 0.f; o1[r] = 0.f; }
    float R = 0.f;
    const bf16_t* vt = Vt + (size_t)(b * 8 + h) * 64 * SEQ;
    for (int k0 = q0; k0 >= 0; k0 -= 32) {
        const bf16_t* kp = Kb + (rowbase + k0 + r32) * 512 + h * 64 + hi * 8;
        bf16x8 kf[4];
#pragma unroll
        for (int ks = 0; ks < 4; ++ks) kf[ks] = *(const bf16x8*)(kp + ks * 16);
        s16x4 vlo[2][2], vhi[2][2];
#pragma unroll
        for (int j = 0; j < 2; ++j)
#pragma unroll
            for (int db = 0; db < 2; ++db) { const bf16_t* vp = vt + (size_t)(32 * db + r32) * SEQ + k0 + 16 * j + 4 * hi; vlo[j][db] = *(const s16x4*)vp; vhi[j][db] = *(const s16x4*)(vp + 8); }
        f32x16 s;
#pragma unroll
        for (int r = 0; r < 16; ++r) s[r] = 0.f;
#pragma unroll
        for (int ks = 0; ks < 4; ++ks) s = MFMA32(kf[ks], qf[ks], s);
        const bool diag = (k0 == q0);
        float Lr[16];
#pragma unroll
        for (int r = 0; r < 16; ++r) {
            const float z = s[r];
            float Lv = fminf(-z, 0.f) - lg2(1.f + ex2(-fabsf(z)));
            if (diag && crow(r, hi) >= r32) Lv = 0.f;
            Lr[r] = Lv;
        }
        float tot[4], oth[4], pr[4];
#pragma unroll
        for (int G = 0; G < 4; ++G) { Lr[4 * G + 2] += Lr[4 * G + 3]; Lr[4 * G + 1] += Lr[4 * G + 2]; Lr[4 * G] += Lr[4 * G + 1]; tot[G] = Lr[4 * G]; }
#pragma unroll
        for (int G = 0; G < 4; ++G) { oth[G] = xshfl<32>(tot[G]); pr[G] = tot[G] + oth[G]; }
        float off[4];
        { const float sp3 = 0.f, sp2 = pr[3], sp1 = sp2 + pr[2], sp0 = sp1 + pr[1];
          off[3] = sp3 + R; off[2] = sp2 + R; off[1] = sp1 + R; off[0] = sp0 + R;
          if (hi == 0) { off[0] += oth[0]; off[1] += oth[1]; off[2] += oth[2]; off[3] += oth[3]; }
          R += sp0 + pr[0]; }
        float w[16];
#pragma unroll
        for (int r = 0; r < 16; ++r) { float wv = ex2(s[r] + Lr[r] + off[r >> 2]); if (diag && crow(r, hi) >= r32) wv = 0.f; w[r] = wv; }
        bf16x8 pa[2];
#pragma unroll
        for (int j = 0; j < 2; ++j) { u32x4 p; p.x = cvt_pk_bf16(w[8 * j], w[8 * j + 1]); p.y = cvt_pk_bf16(w[8 * j + 2], w[8 * j + 3]); p.z = cvt_pk_bf16(w[8 * j + 4], w[8 * j + 5]); p.w = cvt_pk_bf16(w[8 * j + 6], w[8 * j + 7]); pa[j] = __builtin_bit_cast(bf16x8, p); }
#pragma unroll
        for (int j = 0; j < 2; ++j) {
            const bf16x8 v0 = (bf16x8){vlo[j][0][0], vlo[j][0][1], vlo[j][0][2], vlo[j][0][3], vhi[j][0][0], vhi[j][0][1], vhi[j][0][2], vhi[j][0][3]};
            const bf16x8 v1 = (bf16x8){vlo[j][1][0], vlo[j][1][1], vlo[j][1][2], vlo[j][1][3], vhi[j][1][0], vhi[j][1][1], vhi[j][1][2], vhi[j][1][3]};
            o0 = MFMA32(pa[j], v0, o0); o1 = MFMA32(pa[j], v1, o1);
        }
        if (__all(R < -34.f)) break;
    }
#pragma unroll
    for (int r = 0; r < 16; ++r) {
        const size_t row = rowbase + q0 + crow(r, hi);
        MIX[row * 1024 + h * 64 + r32] = f2bf(o0[r]);
        MIX[row * 1024 + h * 64 + 32 + r32] = f2bf(o1[r]);
        float ss = o0[r] * o0[r] + o1[r] * o1[r];
        ss += xshfl<1>(ss); ss += xshfl<2>(ss); ss += xshfl<4>(ss); ss += xshfl<8>(ss); ss += xshfl<16>(ss);
        if (r32 == 0 && do_atomic) atomicAdd(ss_sb + row, ss);
    }
}

__device__ __forceinline__ void conv_task(int task, const bf16_t* HC, const LAS float* wlds, const float* dw_b, const float* ln_g, const float* ln_b, bf16_t* AC, int lane) {
    const int row0 = task * 4, t0 = row0 & (SEQ - 1);
    float acc[4][4];
    { const f32x4 bv = *(const f32x4*)(dw_b + 4 * lane);
#pragma unroll
      for (int tt = 0; tt < 4; ++tt) { acc[tt][0] = bv.x; acc[tt][1] = bv.y; acc[tt][2] = bv.z; acc[tt][3] = bv.w; } }
    u32x2 hv[34];
#pragma unroll
    for (int rr = 0; rr < 34; ++rr) {
        const int t = t0 - 30 + rr;
        u32x2 w = (u32x2){0u, 0u};
        if (t >= 0) w = *(const u32x2*)(HC + (size_t)(row0 - 30 + rr) * 256 + 4 * lane);
        hv[rr] = w;
    }
#pragma unroll
    for (int j = 0; j < 31; ++j) {
        const f32x4 wj = *(const LAS f32x4*)(wlds + j * 256 + 4 * lane);
#pragma unroll
        for (int tt = 0; tt < 4; ++tt) {
            const u32x2 w = hv[tt + j];
            acc[tt][0] += wj.x * bflo(w.x); acc[tt][1] += wj.y * bfhi(w.x); acc[tt][2] += wj.z * bflo(w.y); acc[tt][3] += wj.w * bfhi(w.y);
        }
    }
    const f32x4 gv = *(const f32x4*)(ln_g + 4 * lane), bv2 = *(const f32x4*)(ln_b + 4 * lane);
#pragma unroll
    for (int tt = 0; tt < 4; ++tt) {
        const float mean = wave_sum((acc[tt][0] + acc[tt][1]) + (acc[tt][2] + acc[tt][3])) * (1.f / 256.f);
        const float d0 = acc[tt][0] - mean, d1 = acc[tt][1] - mean, d2 = acc[tt][2] - mean, d3 = acc[tt][3] - mean;
        const float var = wave_sum((d0 * d0 + d1 * d1) + (d2 * d2 + d3 * d3)) * (1.f / 256.f);
        const float rstd = __builtin_amdgcn_rsqf(var + EPS);
        float y0 = d0 * rstd * gv.x + bv2.x, y1 = d1 * rstd * gv.y + bv2.y, y2 = d2 * rstd * gv.z + bv2.z, y3 = d3 * rstd * gv.w + bv2.w;
        y0 *= sigmoidf_(y0); y1 *= sigmoidf_(y1); y2 *= sigmoidf_(y2); y3 *= sigmoidf_(y3);
        u32x2 w; w.x = cvt_pk_bf16(y0, y1); w.y = cvt_pk_bf16(y2, y3);
        *(u32x2*)(AC + (size_t)(row0 + tt) * 256 + 4 * lane) = w;
    }
}

struct SsmW { const float *lam_re, *lam_im, *log_dt, *b_re, *b_im, *c_re, *c_im, *dsk; };
__device__ __forceinline__ u32x4 pack8(const float* v) { u32x4 w; w.x = cvt_pk_bf16(v[0], v[1]); w.y = cvt_pk_bf16(v[2], v[3]); w.z = cvt_pk_bf16(v[4], v[5]); w.w = cvt_pk_bf16(v[6], v[7]); return w; }
template <bool PASSC>
__device__ __forceinline__ void ssm_task(int task, const SsmW& W, const bf16_t* U, f32x2* SST, bf16_t* YS, LAS unsigned char* wl, int lane) {
    const int g = (task >> 7) & 15, b = task >> 11;
    const int c = b ? 127 - (task & 127) : (task & 127);
    const size_t tok0 = (size_t)b * SEQ + c * 64;
    LAS unsigned char* BU = wl;
    LAS unsigned char* xb = wl + 8320;
    const int hh = lane & 15, kq = lane >> 4;
    const float lr = W.lam_re[g * 64 + lane], li = W.lam_im[g * 64 + lane], dt = __expf(W.log_dt[g]);
    const float mag = __expf(lr * dt);
    float sn, cs; { const float ang = li * dt; const float kk = rintf(ang * 0.15915494309189535f); float rr = fmaf(-kk, 6.28125f, ang); rr = fmaf(-kk, 1.9353071795864769e-3f, rr); sn = __sinf(rr); cs = __cosf(rr); }
    const float ar = mag * cs, ai = mag * sn;
    const float den = lr * lr + li * li;
    const float fr = ((ar - 1.f) * lr + ai * li) / den, fi = (ai * lr - (ar - 1.f) * li) / den;
    {
        float bbr[16], bbi[16];
        const f32x4* brp = (const f32x4*)(W.b_re + (size_t)(g * 64 + lane) * 16); const f32x4* bip = (const f32x4*)(W.b_im + (size_t)(g * 64 + lane) * 16);
#pragma unroll
        for (int q = 0; q < 4; ++q) { const f32x4 br = brp[q], bi = bip[q];
#pragma unroll
            for (int j = 0; j < 4; ++j) { bbr[4 * q + j] = fr * br[j] - fi * bi[j]; bbi[4 * q + j] = fr * bi[j] + fi * br[j]; } }
        LAS u32x4* t = (LAS u32x4*)(BU + lane * 64);
        t[0] = pack8(bbr); t[1] = pack8(bbr + 8); t[2] = pack8(bbi); t[3] = pack8(bbi + 8);
    }
    asm volatile("s_waitcnt lgkmcnt(0)" ::: "memory");
    const bf16x8 zfrag = (bf16x8){0, 0, 0, 0, 0, 0, 0, 0};
    bf16x8 bfr[8];
#pragma unroll
    for (int nb = 0; nb < 8; ++nb) bfr[nb] = (kq < 2) ? *(const LAS bf16x8*)(BU + (16 * nb + hh) * 32 + kq * 16) : zfrag;
    bf16x8 cf[4];
    if (PASSC) {
#pragma unroll
        for (int ks = 0; ks < 4; ++ks) {
            const int p0 = 16 * ks + 4 * kq;
            const f32x4 cre = *(const f32x4*)(W.c_re + (size_t)(g * 16 + hh) * 64 + p0), cim = *(const f32x4*)(W.c_im + (size_t)(g * 16 + hh) * 64 + p0);
            u32x4 cw; cw.x = cvt_pk_bf16(cre[0], -cim[0]); cw.y = cvt_pk_bf16(cre[1], -cim[1]); cw.z = cvt_pk_bf16(cre[2], -cim[2]); cw.w = cvt_pk_bf16(cre[3], -cim[3]);
            cf[ks] = __builtin_bit_cast(bf16x8, cw);
        }
    }
    float xr = 0.f, xi = 0.f;
    if (PASSC) {
        float tr = ar, ti = ai;
#pragma unroll
        for (int i = 0; i < 6; ++i) { const float nr = tr * tr - ti * ti, ni = 2.f * tr * ti; tr = nr; ti = ni; }
        const f32x2* sp = SST + ((size_t)(b * 16 + g) * 128) * 64 + lane;
        for (int j0 = 0; j0 < c; j0 += 16) {
            f32x2 sv[16];
#pragma unroll
            for (int q = 0; q < 16; ++q) sv[q] = (j0 + q < c) ? sp[(size_t)(j0 + q) * 64] : (f32x2){0.f, 0.f};
#pragma unroll
            for (int q = 0; q < 16; ++q) if (j0 + q < c) { const float nr = tr * xr - ti * xi + sv[q].x, ni = tr * xi + ti * xr + sv[q].y; xr = nr; xi = ni; }
        }
    }
    const float dk = PASSC ? W.dsk[g * 16 + hh] : 0.f;
    asm volatile("s_waitcnt lgkmcnt(0)" ::: "memory");
#pragma unroll 1
    for (int blk = 0; blk < 4; ++blk) {
        const bf16_t* ub = U + (tok0 + blk * 16) * 256 + g * 16;
        bf16x8 af = zfrag;
        if (kq < 2) af = *(const bf16x8*)(ub + (size_t)hh * 256 + kq * 8);
#pragma unroll
        for (int nb = 0; nb < 8; ++nb) {
            const f32x4 d = MFMA16(af, bfr[nb], ((f32x4){0.f, 0.f, 0.f, 0.f}));
#pragma unroll
            for (int i = 0; i < 4; ++i) *(LAS float*)(BU + (4 * kq + i) * 520 + (16 * nb + hh) * 4) = d[i];
        }
        asm volatile("s_waitcnt lgkmcnt(0)" ::: "memory");
#pragma unroll
        for (int s = 0; s < 16; ++s) {
            const f32x2 bu = *(const LAS f32x2*)(BU + s * 520 + 8 * lane);
            const float nr = ar * xr - ai * xi + bu.x, ni = ar * xi + ai * xr + bu.y; xr = nr; xi = ni;
            if (PASSC) *(LAS unsigned*)(xb + s * 272 + 4 * lane) = cvt_pk_bf16(xr, xi);
        }
        if (PASSC) {
            asm volatile("s_waitcnt lgkmcnt(0)" ::: "memory");
            f32x4 y = (f32x4){0.f, 0.f, 0.f, 0.f};
#pragma unroll
            for (int ks = 0; ks < 4; ++ks) { const bf16x8 a0 = *(const LAS bf16x8*)(xb + hh * 272 + 64 * ks + 16 * kq); y = MFMA16(a0, cf[ks], y); }
#pragma unroll
            for (int i = 0; i < 4; ++i) {
                const size_t e = (size_t)(4 * kq + i) * 256 + hh;
                YS[(tok0 + blk * 16) * 256 + g * 16 + e] = f2bf(y[i] + dk * bf2f(ub[e]));
            }
        }
        asm volatile("s_waitcnt lgkmcnt(0)" ::: "memory");
    }
    if (!PASSC) SST[((size_t)(b * 16 + g) * 128 + c) * 64 + lane] = (f32x2){xr, xi};
}

template <bool PASSC>
__device__ __forceinline__ void ssm_task_old(int task, const SsmW& W, const bf16_t* U, f32x2* SST, bf16_t* YS, LAS unsigned char* wl, int lane) {
    const int c = task & 127, g = (task >> 7) & 15, b = task >> 11;
    const size_t tok0 = (size_t)b * SEQ + c * 64;
    LAS float* uL = (LAS float*)wl;
    LAS unsigned char* xb = wl + 4096;
    {
        const u32x4* up = (const u32x4*)(U + (tok0 + lane) * 256 + g * 16);
        const u32x4 w0 = up[0], w1 = up[1];
        LAS f32x4* d = (LAS f32x4*)(uL + lane * 16);
        d[0] = (f32x4){bflo(w0.x), bfhi(w0.x), bflo(w0.y), bfhi(w0.y)}; d[1] = (f32x4){bflo(w0.z), bfhi(w0.z), bflo(w0.w), bfhi(w0.w)};
        d[2] = (f32x4){bflo(w1.x), bfhi(w1.x), bflo(w1.y), bfhi(w1.y)}; d[3] = (f32x4){bflo(w1.z), bfhi(w1.z), bflo(w1.w), bfhi(w1.w)};
    }
    const float lr = W.lam_re[g * 64 + lane], li = W.lam_im[g * 64 + lane], dt = __expf(W.log_dt[g]);
    const float mag = __expf(lr * dt);
    float sn, cs; { const float ang = li * dt; const float kq = rintf(ang * 0.15915494309189535f); float rr = fmaf(-kq, 6.28125f, ang); rr = fmaf(-kq, 1.9353071795864769e-3f, rr); sn = __sinf(rr); cs = __cosf(rr); }
    const float ar = mag * cs, ai = mag * sn;
    const float den = lr * lr + li * li;
    const float fr = ((ar - 1.f) * lr + ai * li) / den, fi = (ai * lr - (ar - 1.f) * li) / den;
    float bbr[16], bbi[16];
    { const f32x4* brp = (const f32x4*)(W.b_re + (size_t)(g * 64 + lane) * 16); const f32x4* bip = (const f32x4*)(W.b_im + (size_t)(g * 64 + lane) * 16);
#pragma unroll
      for (int q = 0; q < 4; ++q) { const f32x4 br = brp[q], bi = bip[q];
#pragma unroll
          for (int j = 0; j < 4; ++j) { bbr[4 * q + j] = fr * br[j] - fi * bi[j]; bbi[4 * q + j] = fr * bi[j] + fi * br[j]; } } }
    float xr = 0.f, xi = 0.f;
    if (PASSC) {
        float tr = ar, ti = ai;
#pragma unroll
        for (int i = 0; i < 6; ++i) { const float nr = tr * tr - ti * ti, ni = 2.f * tr * ti; tr = nr; ti = ni; }
        const f32x2* sp = SST + ((size_t)(b * 16 + g) * 128) * 64 + lane;
        for (int j0 = 0; j0 < c; j0 += 16) {
            f32x2 sv[16];
#pragma unroll
            for (int q = 0; q < 16; ++q) sv[q] = (j0 + q < c) ? sp[(size_t)(j0 + q) * 64] : (f32x2){0.f, 0.f};
#pragma unroll
            for (int q = 0; q < 16; ++q) if (j0 + q < c) { const float nr = tr * xr - ti * xi + sv[q].x, ni = tr * xi + ti * xr + sv[q].y; xr = nr; xi = ni; }
        }
    }
    asm volatile("s_waitcnt lgkmcnt(0)" ::: "memory");
#pragma unroll 1
    for (int half = 0; half < 2; ++half) {
#pragma unroll 4
        for (int s = 0; s < 32; ++s) {
            const LAS f32x4* ur = (const LAS f32x4*)(uL + (half * 32 + s) * 16);
            float br_ = 0.f, bi_ = 0.f;
#pragma unroll
            for (int q = 0; q < 4; ++q) { const f32x4 uv = ur[q];
#pragma unroll
                for (int j = 0; j < 4; ++j) { br_ = fmaf(bbr[4 * q + j], uv[j], br_); bi_ = fmaf(bbi[4 * q + j], uv[j], bi_); } }
            const float nr = ar * xr - ai * xi + br_, ni = ar * xi + ai * xr + bi_; xr = nr; xi = ni;
            if (PASSC) *(LAS unsigned*)(xb + s * 272 + 4 * lane) = cvt_pk_bf16(xr, xi);
        }
        if (PASSC) {
            asm volatile("s_waitcnt lgkmcnt(0)" ::: "memory");
            const int hh = lane & 15, kq = lane >> 4;
            f32x4 y0 = (f32x4){0.f, 0.f, 0.f, 0.f}, y1 = y0;
#pragma unroll
            for (int ks = 0; ks < 4; ++ks) {
                const int p0 = 16 * ks + 4 * kq;
                const f32x4 cre = *(const f32x4*)(W.c_re + (size_t)(g * 16 + hh) * 64 + p0), cim = *(const f32x4*)(W.c_im + (size_t)(g * 16 + hh) * 64 + p0);
                u32x4 cw; cw.x = cvt_pk_bf16(cre[0], -cim[0]); cw.y = cvt_pk_bf16(cre[1], -cim[1]); cw.z = cvt_pk_bf16(cre[2], -cim[2]); cw.w = cvt_pk_bf16(cre[3], -cim[3]);
                const bf16x8 cf = __builtin_bit_cast(bf16x8, cw);
                const bf16x8 a0 = *(const LAS bf16x8*)(xb + (lane & 15) * 272 + 64 * ks + 16 * kq);
                const bf16x8 a1 = *(const LAS bf16x8*)(xb + (16 + (lane & 15)) * 272 + 64 * ks + 16 * kq);
                y0 = MFMA16(a0, cf, y0); y1 = MFMA16(a1, cf, y1);
            }
            const float dk = W.dsk[g * 16 + hh];
#pragma unroll
            for (int i = 0; i < 4; ++i) {
                const int s0 = 4 * kq + i, s1 = 16 + 4 * kq + i;
                const float v0 = y0[i] + dk * uL[(half * 32 + s0) * 16 + hh], v1 = y1[i] + dk * uL[(half * 32 + s1) * 16 + hh];
                YS[(tok0 + half * 32 + s0) * 256 + g * 16 + hh] = f2bf(v0);
                YS[(tok0 + half * 32 + s1) * 256 + g * 16 + hh] = f2bf(v1);
            }
            asm volatile("s_waitcnt lgkmcnt(0)" ::: "memory");
        }
    }
    if (!PASSC) SST[((size_t)(b * 16 + g) * 128 + c) * 64 + lane] = (f32x2){xr, xi};
}

__device__ __forceinline__ void knorm_task(int task, const float* kraw, const float* kg_all, const float* qg_all, bf16_t* KP, int lane) {
    const int head = task & 3, row = (task >> 2) & 511, lay = task >> 11;
    const f32x4 v = *(const f32x4*)(kraw + ((size_t)lay * 512 + row) * 1024 + head * 256 + 4 * lane);
    const float ss = wave_sum((v.x * v.x + v.y * v.y) + (v.z * v.z + v.w * v.w));
    const float rs = __builtin_amdgcn_rsqf(ss * (1.f / 256.f) + EPS);
    const f32x4 kg = *(const f32x4*)(kg_all + lay * 256 + 4 * lane), qg = *(const f32x4*)(qg_all + lay * 256 + 4 * lane);
    const int b = row >> 8, mt = row & 255;
    u32x2 w; w.x = cvt_pk_bf16(v.x * rs * kg.x * qg.x, v.y * rs * kg.y * qg.y); w.y = cvt_pk_bf16(v.z * rs * kg.z * qg.z, v.w * rs * kg.w * qg.w);
    *(u32x2*)(KP + ((size_t)((lay * 2 + b) * 4 + head) * 256 + mt) * 256 + 4 * lane) = w;
}

__device__ __forceinline__ void xa_task(int task, const bf16_t* XQ, const bf16_t* KPl, const bf16_t* VTMl, bf16_t* XO, int lane) {
    const int r32 = lane & 31, hi = lane >> 5;
    const int qb = task & 255, head = (task >> 8) & 3, b = task >> 10;
    const size_t rowbase = (size_t)b * SEQ; const int q0 = qb * 32;
    float ssq = 0.f;
    const bf16_t* qp = XQ + (rowbase + q0 + r32) * 1024 + head * 256 + hi * 8;
#pragma unroll
    for (int ks = 0; ks < 16; ++ks) { const bf16x8 qv = *(const bf16x8*)(qp + ks * 16);
#pragma unroll
        for (int j = 0; j < 8; ++j) { const float f = bf2f((unsigned short)qv[j]); ssq += f * f; } }
    ssq += xshfl<32>(ssq);
    const float rq = __builtin_amdgcn_rsqf(ssq * (1.f / 256.f) + EPS) * (0.0625f * LOG2E);
    const bf16_t* kbase = KPl + ((size_t)(b * 4 + head) * 256 + r32) * 256 + hi * 8;
    f32x16 sc[8];
#pragma unroll
    for (int kb = 0; kb < 8; ++kb) {
        f32x16 s;
#pragma unroll
        for (int r = 0; r < 16; ++r) s[r] = 0.f;
#pragma unroll
        for (int ks = 0; ks < 16; ++ks) { const bf16x8 kf = *(const bf16x8*)(kbase + (size_t)kb * 32 * 256 + ks * 16); const bf16x8 qv = *(const bf16x8*)(qp + ks * 16); s = MFMA32(kf, qv, s); }
        sc[kb] = s * rq;
        asm volatile("" ::: "memory");
    }
    float mx = -3.0e38f;
#pragma unroll
    for (int kb = 0; kb < 8; ++kb)
#pragma unroll
        for (int r = 0; r < 16; ++r) mx = fmaxf(mx, sc[kb][r]);
    mx = fmaxf(mx, xshfl<32>(mx));
    float sum = 0.f;
#pragma unroll
    for (int kb = 0; kb < 8; ++kb)
#pragma unroll
        for (int r = 0; r < 16; ++r) { const float p = ex2(sc[kb][r] - mx); sc[kb][r] = p; sum += p; }
    sum += xshfl<32>(sum);
    const float inv = __builtin_amdgcn_rcpf(sum);
    bf16x8 pa[8][2];
#pragma unroll
    for (int kb = 0; kb < 8; ++kb)
#pragma unroll
        for (int j = 0; j < 2; ++j) { u32x4 p; p.x = cvt_pk_bf16(sc[kb][8 * j] * inv, sc[kb][8 * j + 1] * inv); p.y = cvt_pk_bf16(sc[kb][8 * j + 2] * inv, sc[kb][8 * j + 3] * inv);
            p.z = cvt_pk_bf16(sc[kb][8 * j + 4] * inv, sc[kb][8 * j + 5] * inv); p.w = cvt_pk_bf16(sc[kb][8 * j + 6] * inv, sc[kb][8 * j + 7] * inv); pa[kb][j] = __builtin_bit_cast(bf16x8, p); }
    const bf16_t* vbase = VTMl + ((size_t)(b * 4 + head) * 256 + r32) * 256 + 4 * hi;
#pragma unroll 1
    for (int db = 0; db < 8; ++db) {
        f32x16 o;
#pragma unroll
        for (int r = 0; r < 16; ++r) o[r] = 0.f;
        const bf16_t* vp = vbase + (size_t)db * 32 * 256;
#pragma unroll
        for (int kb = 0; kb < 8; ++kb)
#pragma unroll
            for (int j = 0; j < 2; ++j) {
                const s16x4 lo = *(const s16x4*)(vp + kb * 32 + 16 * j), hi4 = *(const s16x4*)(vp + kb * 32 + 16 * j + 8);
                const bf16x8 vf = (bf16x8){lo[0], lo[1], lo[2], lo[3], hi4[0], hi4[1], hi4[2], hi4[3]};
                o = MFMA32(pa[kb][j], vf, o);
            }
#pragma unroll
        for (int r = 0; r < 16; ++r) XO[(rowbase + q0 + crow(r, hi)) * 1024 + head * 256 + db * 32 + r32] = f2bf(o[r]);
    }
}

#define XB_TMO      128
#define XB_XCNT(j)  (256  + 64 * (j))
#define XB_XSUB(j)  (1280 + 64 * (j))
#define XB_XGEN(j)  (2304 + 64 * (j))
#define XB_TOP      3328
#define XB_TOPGEN   3392
#define XCD_BAR_WORDS 3456
#define XB_SPIN_CAP (1u << 18)

__device__ __forceinline__ unsigned xb_ld(unsigned* p)              { return __hip_atomic_load(p, __ATOMIC_RELAXED, __HIP_MEMORY_SCOPE_AGENT); }
__device__ __forceinline__ unsigned xb_add(unsigned* p, unsigned v) { return __hip_atomic_fetch_add(p, v, __ATOMIC_RELAXED, __HIP_MEMORY_SCOPE_AGENT); }
__device__ __forceinline__ unsigned xb_xcc_id() { return (unsigned)__builtin_amdgcn_s_getreg((3 << 11) | 20) & 0xFu; }
#define XB_SPIN(cond, bar) do { unsigned _sp = 0; while (cond) { __builtin_amdgcn_s_sleep(1); \
    if ((++_sp & 255u) == 0u) { if (xb_ld(&(bar)[XB_TMO])) break; if (_sp > XB_SPIN_CAP) { atomicAdd(&(bar)[XB_TMO], 1u); break; } } } } while (0)

struct XcdBarrier {
    unsigned* bar; unsigned x;
    volatile LAS unsigned* st;
};

__device__ __forceinline__ XcdBarrier xcd_barrier_post(unsigned* bar, volatile LAS unsigned* st) {
    XcdBarrier b; b.bar = bar; b.x = xb_xcc_id(); b.st = st;
    if (threadIdx.x == 0) (void)xb_add(&bar[XB_XCNT(b.x)], 1u);
    return b;
}
__device__ __forceinline__ void xcd_barrier_complete(unsigned* bar, unsigned x, unsigned& nloc, unsigned& nx) {
    const unsigned G = gridDim.x * gridDim.y * gridDim.z;
    unsigned sum, cnt, mine, sp = 0u;
    for (;;) {
        sum = 0u; cnt = 0u; mine = 0u;
#pragma unroll
        for (unsigned j = 0; j < 16; ++j) { const unsigned c = xb_ld(&bar[XB_XCNT(j)]); sum += c; cnt += (c > 0u) ? 1u : 0u; mine = (j == x) ? c : mine; }
        if (sum == G) break;
        __builtin_amdgcn_s_sleep(1);
        if ((++sp & 255u) == 0u) { if (xb_ld(&bar[XB_TMO])) break; if (sp > XB_SPIN_CAP) { atomicAdd(&bar[XB_TMO], 1u); break; } }
    }
    nloc = mine > 0u ? mine : 1u; nx = cnt > 0u ? cnt : 1u;
}

__device__ __forceinline__ void xcd_barrier(const XcdBarrier& b) {
    asm volatile("s_waitcnt vmcnt(0)" ::: "memory");
    __syncthreads();
    if (threadIdx.x == 0) {
        unsigned* bar = b.bar;
        unsigned bx = (unsigned)__builtin_amdgcn_readfirstlane((int)b.x); asm volatile("" : "+s"(bx));
        __builtin_amdgcn_s_waitcnt(0);
        unsigned nloc = b.st[0], nx = b.st[1];
        if (nloc == 0u) { xcd_barrier_complete(bar, bx, nloc, nx); b.st[0] = nloc; b.st[1] = nx; }
        const unsigned old = xb_add(&bar[XB_XSUB(bx)], 1u);
        const unsigned gen = old / nloc;
        if (old + 1u == (gen + 1u) * nloc) {
            __builtin_amdgcn_fence(__ATOMIC_RELEASE, "agent");
            asm volatile("s_waitcnt vmcnt(0)" ::: "memory");
            const unsigned og = xb_add(&bar[XB_TOP], 1u);
            const unsigned tg = og / nx;
            if (og + 1u == (tg + 1u) * nx) xb_add(&bar[XB_TOPGEN], 1u);
            else XB_SPIN(xb_ld(&bar[XB_TOPGEN]) == tg, bar);
            __builtin_amdgcn_fence(__ATOMIC_ACQUIRE, "agent");
            xb_add(&bar[XB_XGEN(bx)], 1u);
            asm volatile("s_waitcnt vmcnt(0)" ::: "memory");
        } else {
            XB_SPIN(xb_ld(&bar[XB_XGEN(bx)]) == gen, bar);
            __builtin_amdgcn_fence(__ATOMIC_ACQUIRE, "agent");
            asm volatile("s_waitcnt vmcnt(0)" ::: "memory");
        }
    }
    __syncthreads();
}


#ifndef REP_SYNC
#define REP_SYNC 0
#endif
#ifndef REP_PRO
#define REP_PRO 0
#endif
#ifndef REP_XA
#define REP_XA 0
#endif
#ifndef REP_SB
#define REP_SB 0
#endif
#ifndef REP_CONV
#define REP_CONV 0
#endif
#ifndef REP_SSMA
#define REP_SSMA 0
#endif
#ifndef REP_PA
#define REP_PA 0
#endif
#ifndef REP_PJ
#define REP_PJ 0
#endif
#ifndef REP_PC
#define REP_PC 0
#endif
#define GSYNC() do { xcd_barrier(xbar); for (int r_ = 0; r_ < REP_SYNC; ++r_) xcd_barrier(xbar); } while (0)
__global__ void __launch_bounds__(NWAVES * 64, 2) fwd_kernel(KArgs a) {
    extern __shared__ __attribute__((aligned(16))) unsigned char lds_raw[];
    LAS unsigned char* lds = (LAS unsigned char*)lds_raw;
    cg::grid_group grid = cg::this_grid();
    const int wave = __builtin_amdgcn_readfirstlane((int)threadIdx.x >> 6);
    const int G = gridDim.x, vcu = (G % 8 == 0) ? ((int)blockIdx.x % 8) * (G / 8) + (int)blockIdx.x / 8 : (int)blockIdx.x;
    const int gw = vcu * NWAVES + wave, NGW = G * NWAVES;
#define PHASE_PTRS() unsigned char* ws = argp(lds, 34); const int ln = lane_id_asm(); int gwl = launder_i(gw); (void)ln; (void)gwl; unsigned char* wl = ws + WS_W + (size_t)l * WL_STRIDE; (void)wl; \
    bf16_t* XB = (bf16_t*)(ws + WS_XB); bf16_t* Qb = (bf16_t*)(ws + WS_Q); bf16_t* Kb = (bf16_t*)(ws + WS_K); bf16_t* Vt = (bf16_t*)(ws + WS_VT); \
    bf16_t* HC = (bf16_t*)(ws + WS_HC); bf16_t* Ub = (bf16_t*)(ws + WS_U); bf16_t* AC = (bf16_t*)(ws + WS_AC); bf16_t* YS = (bf16_t*)(ws + WS_YS); \
    float* KRAW = (float*)(ws + WS_KRAW); bf16_t* HF = (bf16_t*)(ws + WS_HF); bf16_t* MIX = (bf16_t*)(ws + WS_MIX); bf16_t* XO = (bf16_t*)AOUT(); \
    f32x2* SST = (f32x2*)(ws + WS_SST); bf16_t* KP = (bf16_t*)(ws + WS_KP); bf16_t* VTM = (bf16_t*)(ws + WS_VTM); bf16_t* HMN = (bf16_t*)(ws + WS_HMN); \
    (void)XB; (void)Qb; (void)Kb; (void)Vt; (void)HC; (void)Ub; (void)AC; (void)YS; (void)KRAW; (void)HF; (void)MIX; (void)XO; (void)SST; (void)KP; (void)VTM; (void)HMN;

    if (threadIdx.x < 2) ((volatile LAS unsigned*)(lds + XBST_OFF))[threadIdx.x] = 0u;
    __syncthreads();
    XcdBarrier xbar = xcd_barrier_post((unsigned*)(a.ws + WS_BAR), (volatile LAS unsigned*)(lds + XBST_OFF));
    if (threadIdx.x == 0) {
        volatile LAS unsigned long long* ap = (volatile LAS unsigned long long*)(lds + ARGS_OFF);
#pragma unroll
        for (int i = 0; i < 33; ++i) ap[i] = (unsigned long long)a.in[i];
        ap[33] = (unsigned long long)a.out; ap[34] = (unsigned long long)a.ws;
    }
#ifndef SKIP_PRO
    __syncthreads();
    for (int r_ = 0; r_ <= REP_PRO; ++r_) prologue(a, lds, gw, NGW, wave, lane_id_asm());
#endif
    __syncthreads();
    if (a.ws == nullptr) grid.sync();
    GSYNC();

    for (int l = 0; l < DEPTH; ++l) {
        {
            PHASE_PTRS();
            pg8::Sched S; S.A0 = (const char*)XB; S.B0 = (const char*)(wl + WL_IN); S.nM0 = M / 256; S.nN0 = NIN / 256;
            S.A1 = (const char*)HMN; S.B1 = (const char*)(ws + WS_WKV); S.nM1 = 2; S.nN1 = 16; S.np = (l == 0) ? 2 : 1; S.K = DM; S.G = G; S.c = launder_i(blockIdx.x);
            EpiIn E{ws, l, AIN(4) + l * 64, AIN(5) + l * 64};
#if !defined(SKIP_GEMM) && (!defined(GSEL) || (GSEL & 1))
            for (int r_ = 0; r_ < REP_PA; ++r_) pg8::gemm_phase(lds, S, E, wave);
            pg8::gemm_phase(lds, S, E, wave);
#endif
            if (l == 0) {
                const int first = (G > 96) ? 96 : 0, nb = G - first;
                if ((int)blockIdx.x >= first) {
                    const int ln5 = lane_id_asm(); LAS float* scr = (LAS float*)(lds + wave * 16384);
                    for (int d = ((int)blockIdx.x - first) * NWAVES + wave; d < CI_DSPLIT; d += nb * NWAVES) convert_deferred(lds, ws, d, scr, ln5);
                }
            }
        }
        GSYNC();
        {
            PHASE_PTRS();
            #ifndef SKIP_SB
            { const float* dw = AIN(6) + l * 31 * 256; const int tl = wave * 64 + ln;
              for (int i = tl; i < 31 * 64; i += NWAVES * 64) ((LAS f32x4*)lds)[i] = ((const f32x4*)dw)[i];
              __syncthreads(); }
            for (int r_ = 0; r_ <= REP_SB; ++r_) { const int ln1 = lane_id_asm(); for (int t = gwl; t < 4096; t += NGW) sb_task(t, Qb, Kb, Vt, MIX, SSP(l, SS_SB), ln1, r_ == 0); }
#endif
#ifndef SKIP_CONV
            for (int r_ = 0; r_ <= REP_CONV; ++r_) { const int ln2 = lane_id_asm(); for (int t = gwl; t < M / 4; t += NGW) conv_task(t, HC, (const LAS float*)lds, AIN(7) + l * 256, AIN(8) + l * 256, AIN(9) + l * 256, AC, ln2); }
#endif
            __syncthreads();
            SsmW W{AIN(11) + l * 1024, AIN(12) + l * 1024, AIN(13) + l * 16, AIN(14) + (size_t)l * 16384, AIN(15) + (size_t)l * 16384, AIN(16) + (size_t)l * 16384, AIN(17) + (size_t)l * 16384, AIN(18) + l * 256};
#ifndef SKIP_SSM
            for (int r_ = 0; r_ <= REP_SSMA; ++r_) { const int ln3 = lane_id_asm(); for (int t = gwl; t < 4096; t += NGW) ssm_task_old<false>(t, W, Ub, SST, YS, lds + wave * 16384, ln3); }
#endif
            if (l == 0) { const int ln4 = lane_id_asm(); for (int t = gwl; t < 4096; t += NGW) knorm_task(t, KRAW, AIN(28), AIN(27), KP, ln4); }
        }
        GSYNC();
        {
            PHASE_PTRS();
            SsmW W{AIN(11) + l * 1024, AIN(12) + l * 1024, AIN(13) + l * 16, AIN(14) + (size_t)l * 16384, AIN(15) + (size_t)l * 16384, AIN(16) + (size_t)l * 16384, AIN(17) + (size_t)l * 16384, AIN(18) + l * 256};
#ifndef SKIP_SSM
            for (int r_ = 0; r_ <= REP_PC; ++r_) for (int t = gwl; t < 4096; t += NGW) ssm_task<true>(t, W, Ub, SST, YS, lds + wave * 16384, ln);
#endif
        }
        GSYNC();
        {
            PHASE_PTRS();
            pg8::Sched S; S.A0 = (const char*)AC; S.B0 = (const char*)(wl + WL_PW2); S.nM0 = M / 256; S.nN0 = 1;
            S.A1 = (const char*)YS; S.B1 = (const char*)(wl + WL_GLU); S.nM1 = M / 256; S.nN1 = 2; S.np = 2; S.K = 256; S.G = G; S.c = launder_i(blockIdx.x);
            EpiPwGlu E{ws, l};
#if !defined(SKIP_GEMM) && (!defined(GSEL) || (GSEL & 2))
            pg8::gemm_phase(lds, S, E, wave);
#endif
        }
        GSYNC();
        {
            PHASE_PTRS();
            pg8::Sched S; S.A0 = (const char*)MIX; S.B0 = (const char*)(wl + WL_OUT); S.nM0 = M / 256; S.nN0 = 4; S.A1 = nullptr; S.B1 = nullptr; S.nM1 = 0; S.nN1 = 0; S.np = 1; S.K = DM; S.G = G; S.c = launder_i(blockIdx.x);
            EpiRes E{nullptr, ws, l * 6 + SS_XA, (const LAS float*)(lds + EX_OFF)};
            { pg8::Unit u0; const int tl = wave * 64 + ln;
              if (S.next(0, u0) && tl < 256) {
                  const int row = u0.pm * 256 + tl;
                  const float r1 = __builtin_amdgcn_rsqf(SSP(l, SS_SB)[row] * (1.f / 512.f) + EPS), r2 = __builtin_amdgcn_rsqf(SSP(l, SS_CONV)[row] * (1.f / 256.f) + EPS), r3 = __builtin_amdgcn_rsqf(SSP(l, SS_SSM)[row] * (1.f / 256.f) + EPS);
                  LAS float* fac = (LAS float*)(lds + EX_OFF) + tl * 4;
                  fac[0] = r1 / r2; fac[1] = r2 / r3; fac[2] = r3; }
              __syncthreads(); }
#if !defined(SKIP_GEMM) && (!defined(GSEL) || (GSEL & 4))
            pg8::gemm_phase(lds, S, E, wave, pg8::HookMix{(const LAS float*)(lds + EX_OFF)});
#endif
        }
        GSYNC();
        {
            PHASE_PTRS();
            pg8::Sched S; S.A0 = (const char*)XB; S.B0 = (const char*)(wl + WL_Q); S.nM0 = M / 256; S.nN0 = 4; S.A1 = nullptr; S.B1 = nullptr; S.nM1 = 0; S.nN1 = 0; S.np = 1; S.K = DM; S.G = G; S.c = launder_i(blockIdx.x);
            EpiQ E{ws, l};
#if !defined(SKIP_GEMM) && (!defined(GSEL) || (GSEL & 8))
            pg8::gemm_phase(lds, S, E, wave);
#endif
        }
        if (launder_i(G) != 256) { GSYNC(); }
        else {
            asm volatile("s_waitcnt vmcnt(0)" ::: "memory"); __syncthreads();
            if (threadIdx.x == 0) { __builtin_amdgcn_fence(__ATOMIC_ACQUIRE, "agent"); asm volatile("s_waitcnt vmcnt(0)" ::: "memory"); }
            __syncthreads();
        }
        {
            PHASE_PTRS();
            pg8::SchedXA S; S.A = (const char*)MIX; S.B = (const char*)(KP + (size_t)l * 2 * 4 * 256 * 256); S.K = 256; S.G = G; S.c = launder_i(blockIdx.x);
            EpiSm E{ws, l, lds};
#if !defined(SKIP_GEMM)
            pg8::gemm_phase(lds, S, E, wave);
#endif
        }
        asm volatile("s_waitcnt vmcnt(0)" ::: "memory"); __syncthreads();
        if (threadIdx.x == 0) { __builtin_amdgcn_fence(__ATOMIC_ACQUIRE, "agent"); asm volatile("s_waitcnt vmcnt(0)" ::: "memory"); }
        __syncthreads();
        {
            PHASE_PTRS();
            pg8::SchedXA S; S.A = (const char*)HF; S.B = (const char*)(VTM + (size_t)l * 2 * 4 * 256 * 256); S.K = 256; S.G = G; S.c = launder_i(blockIdx.x);
            EpiPlain E{(unsigned char*)AOUT(), 0};
#if !defined(SKIP_GEMM)
            pg8::gemm_phase(lds, S, E, wave);
#endif
        }
        GSYNC();
        {
            PHASE_PTRS();
            pg8::Sched S; S.A0 = (const char*)XO; S.B0 = (const char*)(wl + WL_O); S.nM0 = M / 256; S.nN0 = 4; S.A1 = nullptr; S.B1 = nullptr; S.nM1 = 0; S.nN1 = 0; S.np = 1; S.K = DM; S.G = G; S.c = launder_i(blockIdx.x);
            EpiRes E{nullptr, ws, l * 6 + SS_FFN, nullptr};
#if !defined(SKIP_GEMM) && (!defined(GSEL) || (GSEL & 16))
            pg8::gemm_phase(lds, S, E, wave);
#endif
        }
        GSYNC();
        {
            PHASE_PTRS();
            pg8::Sched S; S.A0 = (const char*)XB; S.B0 = (const char*)(wl + WL_FFI); S.nM0 = M / 256; S.nN0 = 2 * FFH / 256; S.A1 = nullptr; S.B1 = nullptr; S.nM1 = 0; S.nN1 = 0; S.np = 1; S.K = DM; S.G = G; S.c = launder_i(blockIdx.x);
            EpiFfn E{ws, l};
#if !defined(SKIP_GEMM) && (!defined(GSEL) || (GSEL & 32))
            for (int r_ = 0; r_ < REP_PJ; ++r_) pg8::gemm_phase(lds, S, E, wave);
            pg8::gemm_phase(lds, S, E, wave);
#endif
            if (l == 0) {
                const int first = (G > 128) ? 128 : 0, nb = G - first;
                if ((int)blockIdx.x >= first) {
                    const int ln5 = lane_id_asm(); LAS float* scr = (LAS float*)(lds + wave * 16384);
                    for (int d = CI_DSPLIT + ((int)blockIdx.x - first) * NWAVES + wave; d < CI_DTOT; d += nb * NWAVES) convert_deferred(lds, ws, d, scr, ln5);
                }
            }
        }
        GSYNC();
        {
            PHASE_PTRS();
            pg8::Sched S; S.A0 = (const char*)HF; S.B0 = (const char*)(wl + WL_FFO); S.nM0 = M / 256; S.nN0 = 4; S.A1 = nullptr; S.B1 = nullptr; S.nM1 = 0; S.nN1 = 0; S.np = 1; S.K = FFH; S.G = G; S.c = launder_i(blockIdx.x);
            EpiRes E{(l + 1 < DEPTH) ? nullptr : AOUT(), ws, (l + 1 < DEPTH) ? (l + 1) * 6 + SS_MIX : -1, nullptr};
#if !defined(SKIP_GEMM) && (!defined(GSEL) || (GSEL & 64))
            pg8::gemm_phase(lds, S, E, wave);
#endif
        }
        if (l + 1 < DEPTH) GSYNC();
    }
}

constexpr int LDS_BYTES = 147456;

extern "C" void kernel_launch(void* const* d_in, const int* in_sizes, int n_in, void* d_out, int out_size, void* d_ws, size_t ws_size, hipStream_t stream) {
    static int grid = 0;
    if (grid == 0) {
        int dev = 0, cus = 0, per_cu = 0;
        hipGetDevice(&dev);
        hipDeviceGetAttribute(&cus, hipDeviceAttributeMultiprocessorCount, dev);
        hipFuncSetAttribute((const void*)fwd_kernel, hipFuncAttributeMaxDynamicSharedMemorySize, LDS_BYTES);
        hipOccupancyMaxActiveBlocksPerMultiprocessor(&per_cu, (const void*)fwd_kernel, NWAVES * 64, LDS_BYTES);
        (void)hipGetLastError();
        if (per_cu < 1) per_cu = 1;
        grid = cus;
        if (grid <= 0) grid = 256;
    }
    hipMemsetAsync((char*)d_ws + WS_BAR, 0, 16384, stream);
    KArgs a{};
    for (int i = 0; i < 33; ++i) a.in[i] = (const float*)d_in[i];
    a.out = (float*)d_out; a.ws = (unsigned char*)d_ws;
    void* args[] = {&a};
    hipError_t e = hipLaunchCooperativeKernel((const void*)fwd_kernel, dim3(grid), dim3(NWAVES * 64), args, LDS_BYTES, stream);
    if (e != hipSuccess) fprintf(stderr, "cooperative launch failed: %s (grid %d)\n", hipGetErrorString(e), grid);
}
```
